# Optimizing an MI355X kernel written in HIP

```python
import jax, jax.numpy as jnp
from jax import lax
import numpy as np


D_MODEL = 1024
BATCH = 8
SEQ = 8192
DEPTH = 2

GRID_W = 64
CTX_LEN = 256
HEAD_DIM = 64
A_Q_HEADS = 6
A_KV_HEADS = 2
B_HEADS = 6
C_GROUPS = 4
C_WIDTH = C_GROUPS * HEAD_DIM
A_Q_W = A_Q_HEADS * HEAD_DIM
A_KV_W = A_KV_HEADS * HEAD_DIM
B_W = B_HEADS * HEAD_DIM
Q_W = A_Q_W + B_W
KV_W = 2 * A_KV_W + 2 * B_W
MIX_W = A_Q_W + B_W + C_WIDTH
PROJ_W = Q_W + KV_W + 3 * C_WIDTH
PROJ_SPLIT = (A_Q_W, Q_W, Q_W + KV_W, Q_W + KV_W + C_WIDTH, Q_W + KV_W + 2 * C_WIDTH)
KV_SPLIT = (A_KV_W, 2 * A_KV_W, 2 * A_KV_W + B_W)
Q_BLOCK = 128
WIN_R = 8
WIN_C = 16
ROPE_FREQS = HEAD_DIM // 4
ROPE_THETA = 10000.0
CONV_W = 3
FFN_DIM = 2816
N_MOD = 9
EPS = 1e-6

kernel_name = 'hybrid_parallel_heads_diffusion_block'


def rms_norm(x, g):
    xf = x.astype(jnp.float32)
    y = xf * lax.rsqrt(jnp.mean(xf * xf, axis=-1, keepdims=True) + EPS)
    return y.astype(x.dtype) * g


def heads(t, n):
    return t.reshape(t.shape[:-1] + (n, HEAD_DIM))


def axial_rope_tables(seq, dtype):
    pos = jnp.arange(seq, dtype=jnp.int32)
    row = (pos // GRID_W).astype(jnp.float32)
    col = (pos % GRID_W).astype(jnp.float32)
    freq = 1.0 / (ROPE_THETA ** (jnp.arange(ROPE_FREQS, dtype=jnp.float32) / ROPE_FREQS))
    ang = jnp.stack([row[:, None] * freq, col[:, None] * freq], axis=1)
    return jnp.cos(ang).astype(dtype), jnp.sin(ang).astype(dtype)


def apply_axial_rope(x, cos, sin):
    xr = x.reshape(x.shape[:-1] + (2, 2, ROPE_FREQS))
    x1, x2 = xr[..., 0, :], xr[..., 1, :]
    cs, sn = cos[None, :, None], sin[None, :, None]
    return jnp.stack([x1 * cs - x2 * sn, x2 * cs + x1 * sn], axis=-2).reshape(x.shape)


def gqa_attention(q, k, v):
    bsz, s_len, hq, dh = q.shape
    hkv = k.shape[2]
    grp = hq // hkv
    nb = s_len // Q_BLOCK
    qb = q.reshape(bsz, nb, Q_BLOCK, hkv, grp, dh).transpose(1, 0, 2, 3, 4, 5)
    scale = dh ** -0.5

    def block(qi):
        s = jnp.einsum('bqhgd,bkhd->bhgqk', qi, k).astype(jnp.float32) * scale
        p = jax.nn.softmax(s, axis=-1).astype(v.dtype)
        return jnp.einsum('bhgqk,bkhd->bqhgd', p, v)

    o = lax.map(block, qb)
    return o.transpose(1, 0, 2, 3, 4, 5).reshape(bsz, s_len, hq * dh)


def neighbourhood_attention(q, k, v, k_ctx, v_ctx, rpb, rows):
    bsz, s_len, nh, dh = q.shape
    wr = min(WIN_R, rows)
    n_win = wr * WIN_C
    scale = dh ** -0.5
    qg = q.reshape(bsz, rows, GRID_W, nh, dh)
    kg = k.reshape(bsz, rows, GRID_W, nh, dh)
    vg = v.reshape(bsz, rows, GRID_W, nh, dh)
    col = jnp.arange(GRID_W)
    cs = jnp.clip(col - WIN_C // 2, 0, GRID_W - WIN_C)
    col_idx = cs[:, None] + jnp.arange(WIN_C)[None, :]
    dc_idx = col_idx - col[:, None] + (WIN_C - 1)

    def row_block(r):
        rs = jnp.clip(r - wr // 2, 0, rows - wr)
        qr = lax.dynamic_index_in_dim(qg, r, axis=1, keepdims=False)
        kw = lax.dynamic_slice_in_dim(kg, rs, wr, axis=1)[:, :, col_idx]
        vw = lax.dynamic_slice_in_dim(vg, rs, wr, axis=1)[:, :, col_idx]
        dr_idx = rs + jnp.arange(wr) - r + (WIN_R - 1)
        bias = rpb[:, dr_idx][:, :, dc_idx].transpose(0, 2, 1, 3)
        s_win = jnp.einsum('bqhd,brqjhd->bhqrj', qr, kw).astype(jnp.float32) * scale + bias.astype(jnp.float32)[None]
        s_ctx = jnp.einsum('bqhd,bkhd->bhqk', qr, k_ctx).astype(jnp.float32) * scale
        s = jnp.concatenate([s_win.reshape(bsz, nh, GRID_W, n_win), s_ctx], axis=-1)
        p = jax.nn.softmax(s, axis=-1).astype(v.dtype)
        p_win = p[..., :n_win].reshape(bsz, nh, GRID_W, wr, WIN_C)
        return (jnp.einsum('bhqrj,brqjhd->bqhd', p_win, vw)
                + jnp.einsum('bhqk,bkhd->bqhd', p[..., n_win:], v_ctx))

    o = lax.map(row_block, jnp.arange(rows, dtype=jnp.int32))
    return o.transpose(1, 0, 2, 3, 4).reshape(bsz, s_len, nh * dh)


def short_conv_mixer(xi, gate_b, gate_c, w):
    z = gate_c * xi
    y = lax.conv_general_dilated(z, w[:, None, :], window_strides=(1,),
                                 padding=((CONV_W // 2, CONV_W // 2),),
                                 dimension_numbers=('NWC', 'WIO', 'NWC'),
                                 feature_group_count=z.shape[-1])
    return gate_b * y


def swiglu(u, wi, wo):
    g, up = jnp.split(u @ wi, 2, axis=-1)
    return (jax.nn.silu(g) * up) @ wo


def split_kv(pkv, k_gain):
    ka, va, kb, vb = jnp.split(pkv, KV_SPLIT, axis=-1)
    return (rms_norm(heads(ka, A_KV_HEADS), k_gain), heads(va, A_KV_HEADS),
            heads(kb, B_HEADS), heads(vb, B_HEADS))


def context_mix(p, qk_g, conv_w):
    qa, qb, pkv, cx, cb, cc = jnp.split(p, PROJ_SPLIT, axis=-1)
    ka, va, kb, vb = split_kv(pkv, qk_g[1])
    o_a = gqa_attention(rms_norm(heads(qa, A_Q_HEADS), qk_g[0]), ka, va)
    o_b = gqa_attention(heads(qb, B_HEADS), kb, vb)
    o_c = short_conv_mixer(cx, cb, cc, conv_w)
    return jnp.concatenate([o_a, o_b, o_c], axis=-1), (ka, va, kb, vb)


def latent_mix(p, kv_ctx, cos, sin, qk_g, rpb, conv_w, rows):
    qa, qb, pkv, cx, cb, cc = jnp.split(p, PROJ_SPLIT, axis=-1)
    ka, va, kb, vb = split_kv(pkv, qk_g[1])
    ka_c, va_c, kb_c, vb_c = kv_ctx
    qa = apply_axial_rope(rms_norm(heads(qa, A_Q_HEADS), qk_g[0]), cos, sin)
    ka = apply_axial_rope(ka, cos, sin)
    o_a = gqa_attention(qa, jnp.concatenate([ka, ka_c], axis=1), jnp.concatenate([va, va_c], axis=1))
    o_b = neighbourhood_attention(heads(qb, B_HEADS), kb, vb, kb_c, vb_c, rpb, rows)
    o_c = short_conv_mixer(cx, cb, cc, conv_w)
    return jnp.concatenate([o_a, o_b, o_c], axis=-1)


def hybrid_layer(h, hc, c, c_ctx, w_ada, b_ada, g, w_in, qk_g, rpb, conv_w, w_o, ffn_wi, ffn_wo,
                 cos, sin, rows, last):
    m = (jax.nn.silu(c) @ w_ada + b_ada).reshape(c.shape[0], 1, N_MOD, D_MODEL)
    mc = (jax.nn.silu(c_ctx) @ w_ada + b_ada).reshape(1, 1, N_MOD, D_MODEL)

    def pre(t, mm, i, gi):
        return rms_norm(t, g[gi]) * (1 + mm[:, :, i + 1]) + mm[:, :, i]

    def post(t, y, mm, i, gi, wres):
        return t + wres * mm[:, :, i + 2] * rms_norm(y, g[gi])

    h = post(h, swiglu(pre(h, m, 0, 0), ffn_wi[0], ffn_wo[0]), m, 0, 1, 0.5)
    hc = post(hc, swiglu(pre(hc, mc, 0, 0), ffn_wi[0], ffn_wo[0]), mc, 0, 1, 0.5)
    u = pre(h, m, 3, 2)
    uc = pre(hc, mc, 3, 2)
    if last:
        kv_c = split_kv(uc @ w_in[:, Q_W:Q_W + KV_W], qk_g[1])
    else:
        oc, kv_c = context_mix(uc @ w_in, qk_g, conv_w)
        hc = post(hc, oc @ w_o, mc, 3, 3, 1.0)
    o = latent_mix(u @ w_in, kv_c, cos, sin, qk_g, rpb, conv_w, rows)
    h = post(h, o @ w_o, m, 3, 3, 1.0)
    h = post(h, swiglu(pre(h, m, 6, 4), ffn_wi[1], ffn_wo[1]), m, 6, 5, 0.5)
    if not last:
        hc = post(hc, swiglu(pre(hc, mc, 6, 4), ffn_wi[1], ffn_wo[1]), mc, 6, 5, 0.5)
    return h, hc


def setup_inputs(seed: int = 0) -> dict:
    key = jax.random.key(seed)
    ks = jax.random.split(key, 14)
    nrm = jax.random.normal
    f32 = jnp.float32
    return {
        'x': nrm(ks[0], (BATCH, SEQ, D_MODEL), f32),
        'c': nrm(ks[1], (BATCH, D_MODEL), f32),
        'ctx': nrm(ks[2], (BATCH, CTX_LEN, D_MODEL), f32),
        'c_ctx': nrm(ks[3], (D_MODEL,), f32),
        'w_ada': nrm(ks[4], (DEPTH, D_MODEL, N_MOD * D_MODEL), f32) * (0.5 * D_MODEL ** -0.5),
        'b_ada': 0.01 * nrm(ks[5], (DEPTH, N_MOD * D_MODEL), f32),
        'norm_g': 1.0 + 0.05 * nrm(ks[6], (DEPTH, 6, D_MODEL), f32),
        'w_in': nrm(ks[7], (DEPTH, D_MODEL, PROJ_W), f32) * D_MODEL ** -0.5,
        'qk_g': 1.0 + 0.05 * nrm(ks[8], (DEPTH, 2, HEAD_DIM), f32),
        'rpb': 0.1 * nrm(ks[9], (DEPTH, B_HEADS, 2 * WIN_R - 1, 2 * WIN_C - 1), f32),
        'conv_w': nrm(ks[10], (DEPTH, CONV_W, C_WIDTH), f32) * CONV_W ** -0.5,
        'w_o': nrm(ks[11], (DEPTH, MIX_W, D_MODEL), f32) * MIX_W ** -0.5,
        'ffn_wi': nrm(ks[12], (DEPTH, 2, D_MODEL, 2 * FFN_DIM), f32) * D_MODEL ** -0.5,
        'ffn_wo': nrm(ks[13], (DEPTH, 2, FFN_DIM, D_MODEL), f32) * FFN_DIM ** -0.5,
    }


def reference(x, c, ctx, c_ctx, w_ada, b_ada, norm_g, w_in, qk_g, rpb, conv_w, w_o, ffn_wi, ffn_wo):
    seq = x.shape[1]
    rows = seq // GRID_W
    cos, sin = axial_rope_tables(seq, x.dtype)
    h, hc = x, ctx
    for i in range(DEPTH):
        h, hc = hybrid_layer(h, hc, c, c_ctx, w_ada[i], b_ada[i], norm_g[i], w_in[i], qk_g[i], rpb[i],
                             conv_w[i], w_o[i], ffn_wi[i], ffn_wo[i], cos, sin, rows, i == DEPTH - 1)
    return h
```

```cpp
#define SKEW_K3 8
#define SKEW_K1 21
#define SW_WGM 4
#define IN_WGM 4
#include <hip/hip_runtime.h>
#include <hip/hip_cooperative_groups.h>
#include <cstdio>
#include <cstdint>
namespace pg8 {
#define PG8_LAS __attribute__((address_space(3)))
typedef unsigned short bf16_t;
typedef short bf16x8 __attribute__((ext_vector_type(8)));
typedef float f32x4 __attribute__((ext_vector_type(4)));
typedef unsigned u32x4 __attribute__((ext_vector_type(4)));
constexpr int BM = 256, BK = 64, HALF = 128, HTB = HALF * BK * 2  , STAGE_BYTES = 8 * HTB, NXCD = 8, WGM = 8;

__host__ __device__ __forceinline__ int lds_byte(int r, int c) { const int st = (r >> 4) * 2 + (c >> 5), rr = r & 15, cc = c & 31, ob = rr * 64 + cc * 2; return st * 1024 + (ob ^ (((ob >> 9) & 1) << 5)); }
__host__ __device__ __forceinline__ void stage_rc(int b, int& R, int& C) { const int st = b / 1024, sb = b % 1024, swz = sb ^ (((sb >> 9) & 1) << 5); R = (st >> 1) * 16 + swz / 64; C = (st & 1) * 32 + (swz % 64) / 2; }
__host__ __device__ __forceinline__ int perm32(int rho) { const int n = rho >> 4, i = rho & 15; return 8 * (i >> 2) + 4 * n + (i & 3); }

struct Unit { int pm, pn; };
struct Gemm { const bf16_t* A; const bf16_t* Bt; int M, N, K; };

struct StaticOrder {
    int nM, nN, nwg, G, c;
    __host__ __device__ void init(int M, int N, int G_, int c_) { nM = M / BM; nN = N / BM; nwg = nM * nN; G = G_; c = c_; }
    __host__ __device__ bool next(int i, Unit& u) const {
        const long L = (long)i * G + c; if (L >= nwg) return false;
        int wgid = (int)L; { const int q = nwg / NXCD, r = nwg % NXCD, xcd = wgid % NXCD, off = wgid / NXCD; wgid = (xcd < r ? xcd * (q + 1) : r * (q + 1) + (xcd - r) * q) + off; }
        const int nig = WGM * nN, gid = wgid / nig, fm = gid * WGM, gsz = (nM - fm) < WGM ? (nM - fm) : WGM;
        u.pm = fm + ((wgid % nig) % gsz); u.pn = (wgid % nig) / gsz; return true;
    }
    __device__ __forceinline__ void a_ready(const Unit&) const {}
    __device__ __forceinline__ void done(const Unit&) const {}
};

__device__ __forceinline__ unsigned cvt_pk_bf16(float lo, float hi) { unsigned r; asm volatile("v_cvt_pk_bf16_f32 %0, %1, %2" : "=v"(r) : "v"(lo), "v"(hi)); return r; }
typedef float f32x2 __attribute__((ext_vector_type(2)));
typedef float f32x2 __attribute__((ext_vector_type(2)));
__device__ __forceinline__ u32x4 pack8(const f32x4 v0, const f32x4 v1) { u32x4 w; w.x = cvt_pk_bf16(v0[0], v0[1]); w.y = cvt_pk_bf16(v0[2], v0[3]); w.z = cvt_pk_bf16(v1[0], v1[1]); w.w = cvt_pk_bf16(v1[2], v1[3]); return w; }

struct EpiStore {
    static constexpr bool PERM = true, AFTER_DRAIN = false;
    bf16_t* O; int ldc;
    __device__ __forceinline__ void operator()(const f32x4 (&acc)[2][2][4][2], const Unit& u, int wr, int wc, int fr, int fq) const {
        asm volatile("" : "+v"(fr), "+v"(fq));
        bf16_t* base = O + (size_t)(u.pm * BM + wr * 64 + fr) * ldc + u.pn * BM + wc * 32 + 8 * fq;
#pragma unroll
        for (int ai = 0; ai < 2; ++ai)
#pragma unroll
            for (int m = 0; m < 4; ++m) { bf16_t* rowp = base + (size_t)(ai * HALF + m * 16) * ldc;
#pragma unroll
                for (int bj = 0; bj < 2; ++bj) *(u32x4*)(rowp + bj * HALF) = pack8(acc[ai][bj][m][0], acc[ai][bj][m][1]); }
    }
};

__device__ __forceinline__ float silu_mul(float g, float up) { return g * __builtin_amdgcn_rcpf(1.0f + __builtin_amdgcn_exp2f(-1.4426950408889634f * g)) * up; }
struct EpiSwiglu {
    static constexpr bool PERM = true, AFTER_DRAIN = false;
    bf16_t* O; int ldc;
    __device__ __forceinline__ void operator()(const f32x4 (&acc)[2][2][4][2], const Unit& u, int wr, int wc, int fr, int fq) const {
        asm volatile("" : "+v"(fr), "+v"(fq));
        bf16_t* base = O + (size_t)(u.pm * BM + wr * 64 + fr) * ldc + u.pn * HALF + wc * 32 + 8 * fq;
#pragma unroll
        for (int ai = 0; ai < 2; ++ai)
#pragma unroll
            for (int m = 0; m < 4; ++m) { f32x4 v[2];
#pragma unroll
                for (int n = 0; n < 2; ++n)
#pragma unroll
                    for (int j = 0; j < 4; j += 2) { const f32x2 g = {acc[ai][0][m][n][j], acc[ai][0][m][n][j + 1]}, up = {acc[ai][1][m][n][j], acc[ai][1][m][n][j + 1]};
                        const f32x2 t = g * -1.4426950408889634f; f32x2 d = {__builtin_amdgcn_exp2f(t.x), __builtin_amdgcn_exp2f(t.y)}; d = d + 1.0f;
                        const f32x2 r = {__builtin_amdgcn_rcpf(d.x), __builtin_amdgcn_rcpf(d.y)}; const f32x2 o = (g * up) * r; v[n][j] = o.x; v[n][j + 1] = o.y; }
                *(u32x4*)(base + (size_t)(ai * HALF + m * 16) * ldc) = pack8(v[0], v[1]); }
    }
};

struct EpiInProj {
    static constexpr bool PERM = true, AFTER_DRAIN = false;
    bf16_t* QB; bf16_t* KVB; bf16_t* Z; bf16_t* CB; const float* qkg; const float* ropec; const float* ropes;
    __device__ __forceinline__ void operator()(const f32x4 (&acc)[2][2][4][2], const Unit& u, int wr, int wc, int fr, int fq) const {
        asm volatile("" : "+v"(fr), "+v"(fq));
        const int pm = u.pm, pn = u.pn; const bool lat = pm < 256;
        const int rloc = wr * 64 + fr;
        if (pn >= 7) {
            if (pn == 9) { bf16_t* base = CB + (size_t)(pm * BM + rloc) * 256 + wc * 32 + 8 * fq;
#pragma unroll
                for (int ai = 0; ai < 2; ++ai)
#pragma unroll
                    for (int m = 0; m < 4; ++m)
#pragma unroll
                        for (int bj = 0; bj < 2; ++bj) *(u32x4*)(base + (size_t)(ai * HALF + m * 16) * 256 + bj * HALF) = pack8(acc[ai][bj][m][0], acc[ai][bj][m][1]);
            } else { bf16_t* base = Z + (size_t)(pm * BM + rloc) * 256 + (pn - 7) * HALF + wc * 32 + 8 * fq;
#pragma unroll
                for (int ai = 0; ai < 2; ++ai)
#pragma unroll
                    for (int m = 0; m < 4; ++m) *(u32x4*)(base + (size_t)(ai * HALF + m * 16) * 256) = pack8(acc[ai][0][m][0] * acc[ai][1][m][0], acc[ai][0][m][1] * acc[ai][1][m][1]);
            }
            return;
        }
        const int s = 4 * pn + wc; const bool isq = s < 12; const int nrm = (s < 6) ? 1 : ((s == 12 || s == 13) ? 2 : 0);
        const int kvrow0 = lat ? (pm >> 5) * 8448 + (pm & 31) * 256 : (pm - 256) * 8448 + 8192;
        bf16_t* dst = isq ? QB + (size_t)(pm * BM + rloc) * 768 + 64 * s + 8 * fq : KVB + (size_t)(kvrow0 + rloc) * 1024 + 64 * (s - 12) + 8 * fq;
        const int ld = isq ? 768 : 1024;
        const float qs = isq ? 0.125f * 1.4426950408889634f : 1.0f;
        if (nrm) {
            const float* gq = qkg + (nrm - 1) * 64 + 4 * fq;
#pragma unroll
            for (int ai = 0; ai < 2; ++ai) {
                const int grow = (pm & 31) * 4 + 2 * ai + wr;
#pragma unroll
                for (int m = 0; m < 4; ++m) {
                    float ss = 0.f;
#pragma unroll
                    for (int bj = 0; bj < 2; ++bj)
#pragma unroll
                        for (int n = 0; n < 2; ++n)
#pragma unroll
                            for (int j = 0; j < 4; ++j) ss += acc[ai][bj][m][n][j] * acc[ai][bj][m][n][j];
                    ss += __shfl_xor(ss, 16); ss += __shfl_xor(ss, 32);
                    const float rstd = qs / sqrtf(ss * (1.0f / 64.0f) + 1e-6f);
                    bf16_t* rowp = dst + (size_t)(ai * HALF + m * 16) * ld;
#pragma unroll
                    for (int bj = 0; bj < 2; ++bj) {
                        f32x4 v0 = acc[ai][bj][m][0] * rstd * *(const f32x4*)(gq + 32 * bj), v1 = acc[ai][bj][m][1] * rstd * *(const f32x4*)(gq + 32 * bj + 16);
                        if (lat) {
                            const int pos = bj ? (16 * m + fr) : grow;
                            const f32x4 cc = *(const f32x4*)(ropec + pos * 16 + 4 * fq), sc = *(const f32x4*)(ropes + pos * 16 + 4 * fq);
                            const f32x4 a1 = v0 * cc - v1 * sc, a2 = v1 * cc + v0 * sc; v0 = a1; v1 = a2;
                        }
                        *(u32x4*)(rowp + bj * 32) = pack8(v0, v1);
                    }
                    asm volatile("" ::: "memory");
                }
            }
        } else {
#pragma unroll
            for (int ai = 0; ai < 2; ++ai)
#pragma unroll
                for (int m = 0; m < 4; ++m) { bf16_t* rowp = dst + (size_t)(ai * HALF + m * 16) * ld;
#pragma unroll
                    for (int bj = 0; bj < 2; ++bj) *(u32x4*)(rowp + bj * 32) = pack8(acc[ai][bj][m][0] * qs, acc[ai][bj][m][1] * qs); }
        }
    }
};
template <class Epi, class Sched, bool ALIGN_EPI = false, bool SP2 = false>
__device__ __forceinline__ void gemm_phase(PG8_LAS unsigned char* lds, const Gemm g, const Sched& S, const Epi& E) {
    int tid_ = threadIdx.x; asm volatile("" : "+v"(tid_));
    const int tid = tid_, wid = __builtin_amdgcn_readfirstlane(tid >> 6), lane = tid & 63, wr = wid >> 2, wc = wid & 3; int fr = lane & 15, fq = lane >> 4;
    const int K = g.K, nt = K / BK;
    unsigned voffA[2], voffB[2];
#pragma unroll
    for (int i = 0; i < 2; ++i) { int R, C; stage_rc(tid * 16 + i * 8192, R, C); const int Rb = Epi::PERM ? ((R & ~31) + perm32(R & 31)) : R;
        voffA[i] = (unsigned)(R * K + C) * 2u; voffB[i] = (unsigned)(Rb * K + C) * 2u; }
    const size_t kstep = (size_t)(BK * 2);
    const size_t hstep = (size_t)HALF * K * 2;
    const size_t tstep = 2 * hstep;
    const unsigned ldsw = (unsigned)wid * 1024u;
    const int aoff = lds_byte(wr * 64 + fr, fq * 8), boff = lds_byte(wc * 32 + fr, fq * 8);
#define PG8_SA(b, h) (((b) * 2 + (h)) * HTB)
#define PG8_SB(b, h) ((4 + (b) * 2 + (h)) * HTB)
#define PG8_STAGE(bufoff, gbase, voff) do { _Pragma("unroll") for (int _i = 0; _i < 2; ++_i) \
        __builtin_amdgcn_global_load_lds((const unsigned*)((const char*)(gbase) + (voff)[_i]), (PG8_LAS unsigned*)(lds + (bufoff) + ldsw + _i * 8192), 16, 0, 0); } while (0)
#define PG8_LDA(dst, b, h) do { _Pragma("unroll") for (int m = 0; m < 4; ++m) _Pragma("unroll") for (int k = 0; k < 2; ++k) dst[m][k] = *(const PG8_LAS bf16x8*)(lds + PG8_SA(b, h) + aoff + m * 2048 + k * 1024); } while (0)
#define PG8_LDB(dst, b, h) do { _Pragma("unroll") for (int n = 0; n < 2; ++n) _Pragma("unroll") for (int k = 0; k < 2; ++k) dst[n][k] = *(const PG8_LAS bf16x8*)(lds + PG8_SB(b, h) + boff + n * 2048 + k * 1024); } while (0)
#define PG8_MMA(ai, bj, At, Bt) do { __builtin_amdgcn_s_setprio(1); _Pragma("unroll") for (int m = 0; m < 4; ++m) _Pragma("unroll") for (int n = 0; n < 2; ++n) _Pragma("unroll") for (int k = 0; k < 2; ++k) \
        acc[ai][bj][m][n] = __builtin_amdgcn_mfma_f32_16x16x32_bf16(Bt[n][k], At[m][k], acc[ai][bj][m][n], 0, 0, 0); __builtin_amdgcn_s_setprio(0); } while (0)
#define PG8_WAIT_V(n) asm volatile("s_waitcnt vmcnt(" #n ")" ::: "memory")
#define PG8_WAIT_L(n) asm volatile("s_waitcnt lgkmcnt(" #n ")" ::: "memory")
#define PG8_BAR __builtin_amdgcn_s_barrier()
#define PG8_SCHED __builtin_amdgcn_sched_barrier(0)
    Unit cur, nxt; int ui = 0;
    if (!S.next(0, cur)) return;
    f32x4 acc[2][2][4][2];
#pragma unroll
    for (int a = 0; a < 2; ++a)
#pragma unroll
        for (int b = 0; b < 2; ++b)
#pragma unroll
            for (int m = 0; m < 4; ++m)
#pragma unroll
                for (int n = 0; n < 2; ++n) acc[a][b][m][n] = (f32x4){0.f, 0.f, 0.f, 0.f};
    bf16x8 At[4][2], B0[2][2], B1[2][2];
    const char* cA = (const char*)g.A + (size_t)cur.pm * tstep; const char* cB = (const char*)g.Bt + (size_t)cur.pn * tstep;
    S.a_ready(cur);
    if constexpr (SP2) {
        PG8_STAGE(PG8_SB(0, 0), cB, voffB); PG8_STAGE(PG8_SB(0, 1), cB + hstep, voffB); PG8_STAGE(PG8_SA(0, 0), cA, voffA); PG8_STAGE(PG8_SA(0, 1), cA + hstep, voffA);
        if (wr == 1) PG8_BAR;
        PG8_WAIT_V(2); PG8_BAR;
        PG8_STAGE(PG8_SB(1, 0), cB + kstep, voffB); PG8_STAGE(PG8_SA(1, 0), cA + kstep, voffA); PG8_STAGE(PG8_SB(1, 1), cB + hstep + kstep, voffB);
        PG8_WAIT_V(6); PG8_BAR;
    } else {
        PG8_STAGE(PG8_SB(0, 0), cB, voffB); PG8_STAGE(PG8_SA(0, 0), cA, voffA); PG8_STAGE(PG8_SB(0, 1), cB + hstep, voffB); PG8_STAGE(PG8_SA(0, 1), cA + hstep, voffA);
        if (wr == 1) PG8_BAR;
        PG8_WAIT_V(4); PG8_BAR;
        PG8_STAGE(PG8_SB(1, 0), cB + kstep, voffB); PG8_STAGE(PG8_SA(1, 0), cA + kstep, voffA); PG8_STAGE(PG8_SB(1, 1), cB + hstep + kstep, voffB);
        PG8_WAIT_V(6); PG8_BAR;
    }
    for (;;) {
        const bool has_next = S.next(ui + 1, nxt);
        const char* nA = has_next ? (const char*)g.A + (size_t)nxt.pm * tstep : cA; const char* nB = has_next ? (const char*)g.Bt + (size_t)nxt.pn * tstep : cB;
        for (int t = 0; t < nt; t += 2) {
            const bool last = (t == nt - 2);
            const char* a1 = cA + (size_t)(t + 1) * kstep;
            const char* a2 = last ? nA : cA + (size_t)(t + 2) * kstep; const char* b2 = last ? nB : cB + (size_t)(t + 2) * kstep;
            const char* a3 = a2 + kstep; const char* b3 = b2 + kstep;
            if (last && has_next) S.a_ready(nxt);
            if constexpr (SP2) {
            PG8_LDB(B0, 0, 0); PG8_LDB(B1, 0, 1); PG8_SCHED; PG8_LDA(At, 0, 0); PG8_STAGE(PG8_SA(1, 1), a1 + hstep, voffA);
            PG8_WAIT_V(8); PG8_WAIT_L(0); PG8_BAR; PG8_MMA(0, 0, At, B0); PG8_MMA(0, 1, At, B1); PG8_BAR; PG8_SCHED;
            PG8_LDA(At, 0, 1); PG8_STAGE(PG8_SB(0, 0), b2, voffB); PG8_STAGE(PG8_SB(0, 1), b2 + hstep, voffB); PG8_STAGE(PG8_SA(0, 0), a2, voffA);
            PG8_WAIT_V(8); PG8_WAIT_L(0); PG8_BAR; PG8_MMA(1, 0, At, B0); PG8_MMA(1, 1, At, B1); PG8_BAR; PG8_SCHED;
            PG8_LDB(B0, 1, 0); PG8_LDB(B1, 1, 1); PG8_SCHED; PG8_LDA(At, 1, 0); PG8_STAGE(PG8_SA(0, 1), a2 + hstep, voffA);
            PG8_WAIT_V(8); PG8_WAIT_L(0); PG8_BAR; PG8_MMA(0, 0, At, B0); PG8_MMA(0, 1, At, B1); PG8_BAR; PG8_SCHED;
            PG8_LDA(At, 1, 1); PG8_STAGE(PG8_SB(1, 0), b3, voffB); PG8_STAGE(PG8_SB(1, 1), b3 + hstep, voffB); PG8_STAGE(PG8_SA(1, 0), a3, voffA);
            PG8_WAIT_V(8); PG8_WAIT_L(0); PG8_BAR; PG8_MMA(1, 0, At, B0); PG8_MMA(1, 1, At, B1); PG8_BAR; PG8_SCHED;
            } else {
            PG8_LDB(B0, 0, 0); PG8_SCHED; PG8_LDA(At, 0, 0); PG8_STAGE(PG8_SA(1, 1), a1 + hstep, voffA);
            PG8_WAIT_L(8); PG8_BAR; PG8_WAIT_L(0); PG8_MMA(0, 0, At, B0); PG8_BAR; PG8_SCHED;
            PG8_LDB(B1, 0, 1); PG8_STAGE(PG8_SB(0, 0), b2, voffB);
            PG8_BAR; PG8_WAIT_L(0); PG8_MMA(0, 1, At, B1); PG8_BAR;
            PG8_LDA(At, 0, 1); PG8_STAGE(PG8_SA(0, 0), a2, voffA);
            PG8_BAR; PG8_WAIT_L(0); PG8_MMA(1, 0, At, B0); PG8_BAR; PG8_SCHED;
            PG8_STAGE(PG8_SB(0, 1), b2 + hstep, voffB);
            PG8_WAIT_V(6); PG8_BAR; PG8_MMA(1, 1, At, B1); PG8_BAR;
            PG8_LDB(B0, 1, 0); PG8_SCHED; PG8_LDA(At, 1, 0); PG8_STAGE(PG8_SA(0, 1), a2 + hstep, voffA);
            PG8_WAIT_L(8); PG8_BAR; PG8_WAIT_L(0); PG8_MMA(0, 0, At, B0); PG8_BAR; PG8_SCHED;
            PG8_LDB(B1, 1, 1); PG8_STAGE(PG8_SB(1, 0), b3, voffB);
            PG8_BAR; PG8_WAIT_L(0); PG8_MMA(0, 1, At, B1); PG8_BAR;
            PG8_LDA(At, 1, 1); PG8_STAGE(PG8_SA(1, 0), a3, voffA);
            PG8_BAR; PG8_WAIT_L(0); PG8_MMA(1, 0, At, B0); PG8_BAR; PG8_SCHED;
            PG8_STAGE(PG8_SB(1, 1), b3 + hstep, voffB);
            PG8_WAIT_V(6); PG8_BAR; PG8_MMA(1, 1, At, B1); PG8_BAR;
            }
        }
        if constexpr (ALIGN_EPI) { if (wr == 0) PG8_BAR; }
        if constexpr (!Epi::AFTER_DRAIN) { E(acc, cur, wr, wc, fr, fq); S.done(cur); }
        if (!has_next) break;
#pragma unroll
        for (int a = 0; a < 2; ++a)
#pragma unroll
            for (int b = 0; b < 2; ++b)
#pragma unroll
                for (int m = 0; m < 4; ++m)
#pragma unroll
                    for (int n = 0; n < 2; ++n) acc[a][b][m][n] = (f32x4){0.f, 0.f, 0.f, 0.f};
        cur = nxt; cA = nA; cB = nB; ++ui;
        if constexpr (ALIGN_EPI) { if (wr == 1) PG8_BAR; }
    }
    PG8_WAIT_V(0);
    if constexpr (!ALIGN_EPI) { if (wr == 0) PG8_BAR; }
    PG8_BAR;
    if constexpr (Epi::AFTER_DRAIN) { E.fused(acc, cur, wr, wc, fr, fq, lds, wid, lane); S.done(cur); }
#undef PG8_SA
#undef PG8_SB
#undef PG8_STAGE
#undef PG8_LDA
#undef PG8_LDB
#undef PG8_MMA
#undef PG8_WAIT_V
#undef PG8_WAIT_L
#undef PG8_BAR
#undef PG8_SCHED
}
}
#include <hip/hip_bf16.h>
#include <cmath>
namespace attn_body {
using bf16=__hip_bfloat16;
using bf16x8=__attribute__((ext_vector_type(8)))short;
using s16x4=__attribute__((ext_vector_type(4)))short;
using f32x16=__attribute__((ext_vector_type(16)))float;
using u32x4=__attribute__((ext_vector_type(4)))unsigned;
constexpr int D=64;
constexpr int NW=8,QBLK=32,QB=QBLK*NW,KVBLK=64;
constexpr int ATTN_UNIT_ROWS=QB;
__device__ __forceinline__ int crow(int r,int hi){return (r&3)+8*(r>>2)+4*hi;}
#define SBAR() __builtin_amdgcn_sched_barrier(0)
typedef const __attribute__((address_space(3))) float* lds_cfptr;
__device__ __forceinline__ void bmask(f32x16&p0,f32x16&p1,bool rowok,lds_cfptr brow,int cq,int cs,int hi){
  const float NEG=-INFINITY;
  if(!rowok){
    #pragma unroll
    for(int r=0;r<16;++r){p0[r]=NEG;p1[r]=NEG;}
  } else {
    lds_cfptr bq=brow+(15-cq+4*hi);
    #pragma unroll
    for(int r=0;r<16;++r){const int kc=(r&3)+8*(r>>2); const int kk=kc+4*hi;
      p0[r]=((unsigned)(kk-cs)<16u)?p0[r]+bq[kc]:NEG; p1[r]=((unsigned)(kk+32-cs)<16u)?p1[r]+bq[kc+32]:NEG;}
  }
}
struct AttnJob { const bf16*Q0; const bf16*K0; const bf16*V0; bf16*O0; int qp,kvp,op; int NT,nt0,seg1; int r0,lo; lds_cfptr biasL; };
constexpr int NSLOT=3, SLOTB=8192;
constexpr int LDS_K=0, LDS_V=NSLOT*SLOTB, LDS_WS=2*NSLOT*SLOTB, LDS_OST=LDS_WS+NW*64*4, LDS_BYTES=LDS_OST+NW*4096;
constexpr float C2=0.125f*1.4426950408889634f;
__device__ __forceinline__ void glds16(const void*gsrc,unsigned lds_dst){unsigned keep;
  asm volatile("s_mov_b32 %0, m0\n\ts_mov_b32 m0, %2\n\ts_nop 0\n\tglobal_load_lds_dwordx4 %1, off\n\ts_mov_b32 m0, %0":"=&s"(keep):"v"(gsrc),"s"(lds_dst):"memory");}
__device__ __forceinline__ float max3f(float a,float b,float c){float r;asm("v_max3_f32 %0, %1, %2, %3":"=v"(r):"v"(a),"v"(b),"v"(c));return r;}
__device__ __forceinline__ float max2f(float a,float b){float r;asm("v_max_f32_e32 %0, %1, %2":"=v"(r):"v"(a),"v"(b));return r;}
__device__ __forceinline__ float fadd_s(float a,float b){float r;asm("v_add_f32_e32 %0, %1, %2":"=v"(r):"v"(a),"v"(b));return r;}
__device__ __forceinline__ float fsub_s(float a,float b){float r;asm("v_sub_f32_e32 %0, %1, %2":"=v"(r):"v"(a),"v"(b));return r;}
typedef float f32x2_t __attribute__((ext_vector_type(2))); typedef __bf16 bf16x2_t __attribute__((ext_vector_type(2)));
__device__ __forceinline__ unsigned cvtpk_s(float lo,float hi){f32x2_t v={lo,hi};bf16x2_t b=__builtin_convertvector(v,bf16x2_t);return __builtin_bit_cast(unsigned,b);}
#define WAIT_BAR(N) asm volatile("s_waitcnt vmcnt(" #N ") lgkmcnt(0)\n\ts_barrier":::"memory")

__device__ __forceinline__ void qkt(f32x16&p0,f32x16&p1,const char*Kslot,const bf16x8*qr,const f32x16&negm,int r32,int hi){
  const char*kb=Kslot+hi*1024+r32*16;
  #pragma unroll
  for(int d0=0;d0<4;++d0){
    const bf16x8 b0=*reinterpret_cast<const bf16x8*>(kb+d0*2048);
    const bf16x8 b1=*reinterpret_cast<const bf16x8*>(kb+d0*2048+512);
    if(d0==0){p0=__builtin_amdgcn_mfma_f32_32x32x16_bf16(b0,qr[0],negm,0,0,0);p1=__builtin_amdgcn_mfma_f32_32x32x16_bf16(b1,qr[0],negm,0,0,0);}
    else{p0=__builtin_amdgcn_mfma_f32_32x32x16_bf16(b0,qr[d0],p0,0,0,0);p1=__builtin_amdgcn_mfma_f32_32x32x16_bf16(b1,qr[d0],p1,0,0,0);}}
}
typedef __attribute__((address_space(3))) const char* lds_cptr;
typedef short v4i16_t __attribute__((ext_vector_type(4)));
__device__ __forceinline__ void kload8(bf16x8*kf,lds_cptr kp){
  kf[0]=*(const __attribute__((address_space(3))) bf16x8*)(kp);      kf[1]=*(const __attribute__((address_space(3))) bf16x8*)(kp+512);
  kf[2]=*(const __attribute__((address_space(3))) bf16x8*)(kp+2048); kf[3]=*(const __attribute__((address_space(3))) bf16x8*)(kp+2560);
  kf[4]=*(const __attribute__((address_space(3))) bf16x8*)(kp+4096); kf[5]=*(const __attribute__((address_space(3))) bf16x8*)(kp+4608);
  kf[6]=*(const __attribute__((address_space(3))) bf16x8*)(kp+6144); kf[7]=*(const __attribute__((address_space(3))) bf16x8*)(kp+6656);
}
__device__ __forceinline__ void kload2(bf16x8*kf,lds_cptr kp,int j){ kf[2*j]=*(const __attribute__((address_space(3))) bf16x8*)(kp+j*2048); kf[2*j+1]=*(const __attribute__((address_space(3))) bf16x8*)(kp+j*2048+512); }
__device__ __forceinline__ s16x4 vtr(lds_cptr p){ return __builtin_bit_cast(s16x4,__builtin_amdgcn_ds_read_tr16_b64_v4i16((__attribute__((address_space(3))) v4i16_t*)p)); }
__device__ __forceinline__ float rowmax(const f32x16&p0,const f32x16&p1){
  float a=max3f(p0[0],p0[1],p1[0]),b=max3f(p0[2],p0[3],p1[1]);a=max3f(a,p1[2],p1[3]);
  #pragma unroll
  for(int r=4;r<16;r+=4){a=max3f(a,p0[r],p0[r+1]);b=max3f(b,p0[r+2],p0[r+3]);a=max3f(a,p1[r],p1[r+1]);b=max3f(b,p1[r+2],p1[r+3]);}
  const float m=max2f(a,b);
  auto rr=__builtin_amdgcn_permlane32_swap(__float_as_uint(m),__float_as_uint(m),false,false);
  return max2f(__uint_as_float(rr[0]),__uint_as_float(rr[1]));
}
__device__ __forceinline__ void pv(f32x16*o,int vb,bf16x8 pa0,bf16x8 pa1,bf16x8 pa2,bf16x8 pa3){
  #pragma unroll
  for(int d0=0;d0<2;++d0){s16x4 lo[4],hi[4];
    #pragma unroll
    for(int ks=0;ks<4;++ks){
      asm volatile("ds_read_b64_tr_b16 %0,%1 offset:%c2":"=&v"(lo[ks]):"v"(vb),"i"(d0*4096+ks*1024):"memory");
      asm volatile("ds_read_b64_tr_b16 %0,%1 offset:%c2":"=&v"(hi[ks]):"v"(vb),"i"(d0*4096+ks*1024+512):"memory");}
    asm volatile("s_waitcnt lgkmcnt(0)":::"memory");SBAR();
    #define PK(k) (bf16x8){lo[k][0],lo[k][1],lo[k][2],lo[k][3],hi[k][0],hi[k][1],hi[k][2],hi[k][3]}
    o[d0]=__builtin_amdgcn_mfma_f32_32x32x16_bf16(pa0,PK(0),o[d0],0,0,0);
    o[d0]=__builtin_amdgcn_mfma_f32_32x32x16_bf16(pa1,PK(1),o[d0],0,0,0);
    o[d0]=__builtin_amdgcn_mfma_f32_32x32x16_bf16(pa2,PK(2),o[d0],0,0,0);
    o[d0]=__builtin_amdgcn_mfma_f32_32x32x16_bf16(pa3,PK(3),o[d0],0,0,0);
    #undef PK
  }
}

#ifndef ATTN_STORE16
#define ATTN_STORE16(p,v) (*(u32x4*)(p)=(v))
#endif
template<int THRL,int MODE> __device__ __forceinline__ void attn_unit(const AttnJob&J,char*shm){
  int tid_=threadIdx.x; asm volatile("":"+v"(tid_)); const int tid=tid_,lane=tid&63,r32=lane&31,hi=lane>>5; const int wid=__builtin_amdgcn_readfirstlane(tid>>6);
  const int QP=J.qp,KVP=J.kvp,OP=J.op,nt0=J.nt0,seg1=J.seg1;
  const bf16*Qw=J.Q0+(long)(wid*QBLK)*QP;
  const bf16*Kh=J.K0,*Vh=J.V0;
  const unsigned lds0=(unsigned)(uintptr_t)shm;
  float*wsf=(float*)(shm+LDS_WS)+wid*64;
  const bf16*ksrc=Kh+(long)lane*KVP+wid*8;
  const bf16*vsrc=Vh+(long)(16*(wid&3)+(lane>>2))*KVP+(wid>>2)*32+(lane&3)*8;
  const unsigned kdst=lds0+LDS_K+wid*1024, vdst=lds0+LDS_V+wid*1024;
  #define TROW(t) (((t)<nt0)?(t)*KVBLK:seg1+((t)-nt0)*KVBLK)
  #define DMA_K(t,slot) glds16(ksrc+(long)TROW(t)*KVP,(unsigned)__builtin_amdgcn_readfirstlane(kdst+(slot)))
  #define DMA_V(t,slot) glds16(vsrc+(long)TROW(t)*KVP,(unsigned)__builtin_amdgcn_readfirstlane(vdst+(slot)))
  const int vb0=(int)(lds0+LDS_V)+((lane>>4)&1)*32+(lane&3)*8+(4*hi+((lane&15)>>2))*64;
  const char*Kbase=shm+LDS_K; bf16x8 kf[8];
  const lds_cptr shm3=(lds_cptr)shm; const lds_cptr kp0=shm3+LDS_K+hi*1024+r32*16; const lds_cptr vp0=shm3+LDS_V+((lane>>4)&1)*32+(lane&3)*8+(4*hi+((lane&15)>>2))*64;
  const int NT=J.NT;
  DMA_K(0,0);DMA_V(0,0);DMA_K(1,SLOTB);
  bf16x8 qr[4];
  #pragma unroll
  for(int d0=0;d0<4;++d0)qr[d0]=*reinterpret_cast<const bf16x8*>(&Qw[(long)r32*QP+d0*16+hi*8]);
  float mhat=0.f,l_reg=0.f;f32x16 o[2];o[0]=f32x16{};o[1]=f32x16{};f32x16 negm=f32x16{};asm volatile("":"+v"(negm));
  const int rq_=J.r0+(wid>>1),cq_=32*(wid&1)+r32; const int rs_=min(max(rq_-4,0),120),cs_=min(max(cq_-8,0),48);
  #define CMASK(P0,P1,t) do{ if constexpr(MODE==1){ if((t)>=nt0){ const int kr_=J.lo+((t)-nt0); bmask(P0,P1,(kr_>=rs_&&kr_<rs_+8),J.biasL+(kr_-rq_+7)*31,cq_,cs_,hi); } } }while(0)
  bool resc=false;
  #define START(P0,P1) do{ const float rm=rowmax(P0,P1); resc=false; \
    { const float dl=rm; mhat=fadd_s(mhat,dl); \
      _Pragma("unroll") for(int r=0;r<16;++r){P0[r]=fsub_s(P0[r],dl);P1[r]=fsub_s(P1[r],dl);} \
      _Pragma("unroll") for(int r=0;r<16;++r)negm[r]=-mhat; asm volatile("":"+v"(negm)); } \
    _Pragma("unroll") for(int r=0;r<16;++r)P0[r]=__builtin_amdgcn_exp2f(P0[r]); }while(0)
  #define RESC() do{ if(resc){ asm volatile("s_waitcnt lgkmcnt(0)":::"memory"); \
      _Pragma("unroll") for(int d_=0;d_<2;++d_) _Pragma("unroll") for(int r=0;r<16;++r)o[d_][r]*=wsf[crow(r,hi)]; } }while(0)
  f32x16 pA0,pA1,pB0,pB1;
  int sl_prev=0,sl_cur=0,sl_next=SLOTB;
  #define ROT() do{sl_prev=sl_cur;sl_cur=sl_next;sl_next=(sl_next==(NSLOT-1)*SLOTB)?0:sl_next+SLOTB;}while(0)
  DMA_K(2,2*SLOTB);
  WAIT_BAR(3);
  qkt(pA0,pA1,Kbase,qr,negm,r32,hi);asm volatile("s_nop 15\n\ts_nop 7":"+v"(pA0),"+v"(pA1));CMASK(pA0,pA1,0);
  START(pA0,pA1);
  _Pragma("unroll") for(int r=0;r<16;++r)pA1[r]=__builtin_amdgcn_exp2f(pA1[r]);
  WAIT_BAR(0);
  DMA_K(3,0);DMA_V(1,SLOTB);
  ROT();
  kload8(kf,kp0+sl_cur);
  WAIT_BAR(2);
  s16x4 vlo[8],vhi[8]; u32x4 pw0,pw1,pw2,pw3;
  #define PKW(P,B) cvtpk_s(P[B],P[B+1])
  #define PAF(k) __builtin_bit_cast(bf16x8,pw##k)
  #define VFR(i) (bf16x8){vlo[i][0],vlo[i][1],vlo[i][2],vlo[i][3],vhi[i][0],vhi[i][1],vhi[i][2],vhi[i][3]}
  #define PIN(x) asm volatile("":"+v"(x))
  #define MX3(a,b,c) __builtin_fmaxf(__builtin_fmaxf((a),(b)),(c))
  #define GAPA(MF,A0,A1,A2,A3,W0,W1,PW) do{ MF; sacc+=A0; sacc+=A1; sacc+=A2; sacc+=A3; PIN(sacc); W0; W1; PIN(PW); SBAR(); }while(0)
  #define EX(v) __builtin_amdgcn_exp2f(v)
  #define GAPB(MF,X,B) do{ MF; X[B]=EX(X[B]); X[B+1]=EX(X[B+1]); X[B+2]=EX(X[B+2]); X[B+3]=EX(X[B+3]); PIN(X); SBAR(); }while(0)
  #define VRD(i) do{ vlo[i]=vtr(vp_+(((i)>>2)*4096+((i)&3)*1024)); vhi[i]=vtr(vp_+(((i)>>2)*4096+((i)&3)*1024+512)); }while(0)
  #define KRD(G,j) do{ if(G){ kload2(kf,kp0+sl_next,j); SBAR(); } }while(0)
  #define STEP(C0,C1,P0,P1,t,GK,GV,GL) do{ SBAR(); \
    const lds_cptr vp_=vp0+sl_prev; \
    VRD(0); SBAR(); float sacc=(P0[0]+P0[1]); \
    GAPA(C0=__builtin_amdgcn_mfma_f32_32x32x16_bf16(kf[0],qr[0],negm,0,0,0), P0[2],P0[3],P0[4],P0[5],     pw0[0]=PKW(P0,0), pw0[1]=PKW(P0,2), pw0); \
    VRD(4); SBAR(); GAPA(C1=__builtin_amdgcn_mfma_f32_32x32x16_bf16(kf[1],qr[0],negm,0,0,0), P0[6],P0[7],P0[8],P0[9],     pw0[2]=PKW(P0,4), pw0[3]=PKW(P0,6), pw0); \
    VRD(1); SBAR(); GAPA(C0=__builtin_amdgcn_mfma_f32_32x32x16_bf16(kf[2],qr[1],C0,0,0,0),   P0[10],P0[11],P0[12],P0[13], pw1[0]=PKW(P0,8), pw1[1]=PKW(P0,10), pw1); \
    VRD(5); SBAR(); GAPA(C1=__builtin_amdgcn_mfma_f32_32x32x16_bf16(kf[3],qr[1],C1,0,0,0),   P0[14],P0[15],P1[0],P1[1],   pw1[2]=PKW(P0,12),pw1[3]=PKW(P0,14), pw1); \
    VRD(2); SBAR(); GAPA(C0=__builtin_amdgcn_mfma_f32_32x32x16_bf16(kf[4],qr[2],C0,0,0,0),   P1[2],P1[3],P1[4],P1[5],     pw2[0]=PKW(P1,0), pw2[1]=PKW(P1,2), pw2); \
    VRD(6); SBAR(); GAPA(C1=__builtin_amdgcn_mfma_f32_32x32x16_bf16(kf[5],qr[2],C1,0,0,0),   P1[6],P1[7],P1[8],P1[9],     pw2[2]=PKW(P1,4), pw2[3]=PKW(P1,6), pw2); \
    VRD(3); SBAR(); GAPA(C0=__builtin_amdgcn_mfma_f32_32x32x16_bf16(kf[6],qr[3],C0,0,0,0),   P1[10],P1[11],P1[12],P1[13], pw3[0]=PKW(P1,8), pw3[1]=PKW(P1,10), pw3); \
    VRD(7); SBAR(); GAPA(C1=__builtin_amdgcn_mfma_f32_32x32x16_bf16(kf[7],qr[3],C1,0,0,0),   P1[14],P1[15],0.f,0.f,       pw3[2]=PKW(P1,12),pw3[3]=PKW(P1,14), pw3); \
    l_reg+=sacc; \
    if(GK){DMA_K((t)+3,sl_cur);} if(GV){DMA_V((t)+1,sl_next);} \
    CMASK(C0,C1,t); \
    { float a=MX3(C0[0],C0[1],C1[0]),b=MX3(C0[2],C0[3],C1[1]); a=MX3(a,C1[2],C1[3]); \
      _Pragma("unroll") for(int r=4;r<16;r+=4){a=MX3(a,C0[r],C0[r+1]);b=MX3(b,C0[r+2],C0[r+3]);a=MX3(a,C1[r],C1[r+1]);b=MX3(b,C1[r+2],C1[r+3]);} \
      float rm=__builtin_fmaxf(a,b); { auto rr=__builtin_amdgcn_permlane32_swap(__float_as_uint(rm),__float_as_uint(rm),false,false); rm=__builtin_fmaxf(__uint_as_float(rr[0]),__uint_as_float(rr[1])); } \
      resc=false; \
      if(__builtin_expect(__any(rm>(float)THRL),0)){ const float dl=__builtin_fmaxf(rm,0.f); mhat+=dl; \
        _Pragma("unroll") for(int r=0;r<16;++r){C0[r]-=dl;C1[r]-=dl;} \
        _Pragma("unroll") for(int r=0;r<16;++r)negm[r]=-mhat; asm volatile("":"+v"(negm)); \
        const float f=__builtin_amdgcn_exp2f(-dl); l_reg*=f; if(hi==0)wsf[r32]=f; resc=true; } } \
    SBAR(); \
    GAPB(o[0]=__builtin_amdgcn_mfma_f32_32x32x16_bf16(PAF(0),VFR(0),o[0],0,0,0), C0,0); \
    GAPB(o[1]=__builtin_amdgcn_mfma_f32_32x32x16_bf16(PAF(0),VFR(4),o[1],0,0,0), C0,4); \
    KRD(GL,0); GAPB(o[0]=__builtin_amdgcn_mfma_f32_32x32x16_bf16(PAF(1),VFR(1),o[0],0,0,0), C0,8); \
    KRD(GL,1); GAPB(o[1]=__builtin_amdgcn_mfma_f32_32x32x16_bf16(PAF(1),VFR(5),o[1],0,0,0), C0,12); \
    KRD(GL,2); GAPB(o[0]=__builtin_amdgcn_mfma_f32_32x32x16_bf16(PAF(2),VFR(2),o[0],0,0,0), C1,0); \
    KRD(GL,3); GAPB(o[1]=__builtin_amdgcn_mfma_f32_32x32x16_bf16(PAF(2),VFR(6),o[1],0,0,0), C1,4); \
    GAPB(o[0]=__builtin_amdgcn_mfma_f32_32x32x16_bf16(PAF(3),VFR(3),o[0],0,0,0), C1,8); \
    GAPB(o[1]=__builtin_amdgcn_mfma_f32_32x32x16_bf16(PAF(3),VFR(7),o[1],0,0,0), C1,12); \
    }while(0)
  int t=1;
  #undef CMASK
  #define CMASK(P0,P1,t) do{ if constexpr(MODE==1){ if((t)>=nt0){ const int kr_=J.lo+((t)-nt0); bmask(P0,P1,(kr_>=rs_&&kr_<rs_+8),J.biasL+(kr_-rq_+7)*31,cq_,cs_,hi); } } }while(0)
  for(;t+5<NT;t+=2){
    STEP(pB0,pB1,pA0,pA1,t,true,true,true);     WAIT_BAR(2); RESC(); ROT();
    STEP(pA0,pA1,pB0,pB1,t+1,true,true,true);   WAIT_BAR(2); RESC(); ROT();
  }
  #undef CMASK
  #define CMASK(P0,P1,t) do{ if constexpr(MODE==1){ if((t)>=nt0){ const int kr_=J.lo+((t)-nt0); bmask(P0,P1,(kr_>=rs_&&kr_<rs_+8),J.biasL+(kr_-rq_+7)*31,cq_,cs_,hi); } } }while(0)
  #define ENDW(tt) do{ if((tt)+3<NT){WAIT_BAR(2);} else if((tt)+2<NT){WAIT_BAR(1);} else {WAIT_BAR(0);} }while(0)
  for(;t+1<NT;t+=2){
    STEP(pB0,pB1,pA0,pA1,t,(t+3<NT),(t+1<NT),(t+1<NT));       ENDW(t);   RESC(); ROT();
    STEP(pA0,pA1,pB0,pB1,t+1,(t+4<NT),(t+2<NT),(t+2<NT));     ENDW(t+1); RESC(); ROT();
  }
  STEP(pB0,pB1,pA0,pA1,NT-1,false,false,false); RESC();
  { float sacc=pB0[0]+pB0[1]; _Pragma("unroll") for(int r=2;r<16;++r)sacc+=pB0[r]; _Pragma("unroll") for(int r=0;r<16;++r)sacc+=pB1[r]; l_reg+=sacc;
    pw0=(u32x4){PKW(pB0,0),PKW(pB0,2),PKW(pB0,4),PKW(pB0,6)};pw1=(u32x4){PKW(pB0,8),PKW(pB0,10),PKW(pB0,12),PKW(pB0,14)};pw2=(u32x4){PKW(pB1,0),PKW(pB1,2),PKW(pB1,4),PKW(pB1,6)};pw3=(u32x4){PKW(pB1,8),PKW(pB1,10),PKW(pB1,12),PKW(pB1,14)};
    SBAR(); pv(o,vb0+sl_cur,PAF(0),PAF(1),PAF(2),PAF(3)); }
  #undef PKW
  #undef PAF
  #undef VFR
  #undef PIN
  #undef MX3
  #undef GAPA
  #undef GAPB
  #undef EX
  #undef VRD
  #undef KRD
  #undef STEP
  #undef ENDW
  {auto rr=__builtin_amdgcn_permlane32_swap(__float_as_uint(l_reg),__float_as_uint(l_reg),false,false);l_reg=__uint_as_float(rr[0])+__uint_as_float(rr[1]);}
  if(hi==0)wsf[32+r32]=l_reg;asm volatile("s_waitcnt lgkmcnt(0)":::"memory");
  float rli[16];
  #pragma unroll
  for(int r=0;r<16;++r)rli[r]=__builtin_amdgcn_rcpf(wsf[32+crow(r,hi)]);
  bf16*Ow=J.O0+(long)(wid*QBLK)*OP;
  { bf16*stg=(bf16*)(shm+LDS_OST)+wid*2048;
    #pragma unroll
    for(int r=0;r<16;++r){const int orow=crow(r,hi);
      #pragma unroll
      for(int d0=0;d0<2;++d0)stg[orow*64+d0*32+r32]=__float2bfloat16(o[d0][r]*rli[r]);}
    asm volatile("s_waitcnt lgkmcnt(0)":::"memory");
    #pragma unroll
    for(int i=0;i<4;++i){const int row=i*8+(lane>>3),ch=lane&7; const u32x4 v=*(const u32x4*)(stg+row*64+ch*8); ATTN_STORE16(Ow+(long)row*OP+ch*8,v);} }
  asm volatile("s_waitcnt lgkmcnt(0)\n\ts_barrier":::"memory");
  #undef DMA_K
  #undef DMA_V
  #undef TROW
  #undef CMASK
  #undef START
  #undef RESC
  #undef ROT
}
constexpr int ATTN_LDS_BYTES=LDS_BYTES;
#undef SBAR
#undef WAIT_BAR
}
#define GAS __attribute__((address_space(1)))
#define LAS __attribute__((address_space(3)))
#define XB_TMO      128
#define XB_XCNT(j)  (256  + 64 * (j))
#define XB_XSUB(j)  (1280 + 64 * (j))
#define XB_XGEN(j)  (2304 + 64 * (j))
#define XB_TOP      3328
#define XB_TOPGEN   3392
#define XCD_BAR_WORDS 3456
#define XB_SPIN_CAP (1u << 18)

__device__ __forceinline__ unsigned xb_ld(unsigned* p)              { return __hip_atomic_load(p, __ATOMIC_RELAXED, __HIP_MEMORY_SCOPE_AGENT); }
__device__ __forceinline__ unsigned xb_add(unsigned* p, unsigned v) { return __hip_atomic_fetch_add(p, v, __ATOMIC_RELAXED, __HIP_MEMORY_SCOPE_AGENT); }
__device__ __forceinline__ unsigned xb_xcc_id() { return (unsigned)__builtin_amdgcn_s_getreg((3 << 11) | 20) & 0xFu; }
#define XB_SPIN(cond, bar) do { unsigned _sp = 0; while (cond) { __builtin_amdgcn_s_sleep(1); \
    if ((++_sp & 255u) == 0u) { if (xb_ld(&(bar)[XB_TMO])) break; if (_sp > XB_SPIN_CAP) { atomicAdd(&(bar)[XB_TMO], 1u); break; } } } } while (0)

struct XcdBarrier {
    unsigned* bar; unsigned x;
    volatile LAS unsigned* st;
};

__device__ __forceinline__ XcdBarrier xcd_barrier_post(unsigned* bar, volatile LAS unsigned* st) {
    XcdBarrier b; b.bar = bar; b.x = xb_xcc_id(); b.st = st;
    if (threadIdx.x == 0) (void)xb_add(&bar[XB_XCNT(b.x)], 1u);
    return b;
}
__device__ __forceinline__ void xcd_barrier_complete(unsigned* bar, unsigned x, unsigned& nloc, unsigned& nx) {
    const unsigned G = gridDim.x * gridDim.y * gridDim.z;
    unsigned sum, cnt, mine, sp = 0u;
    for (;;) {
        sum = 0u; cnt = 0u; mine = 0u;
#pragma unroll
        for (unsigned j = 0; j < 16; ++j) { const unsigned c = xb_ld(&bar[XB_XCNT(j)]); sum += c; cnt += (c > 0u) ? 1u : 0u; mine = (j == x) ? c : mine; }
        if (sum == G) break;
        __builtin_amdgcn_s_sleep(1);
        if ((++sp & 255u) == 0u) { if (xb_ld(&bar[XB_TMO])) break; if (sp > XB_SPIN_CAP) { atomicAdd(&bar[XB_TMO], 1u); break; } }
    }
    nloc = mine > 0u ? mine : 1u; nx = cnt > 0u ? cnt : 1u;
}

__device__ __forceinline__ void xcd_barrier(const XcdBarrier& b) {
    asm volatile("s_waitcnt vmcnt(0)" ::: "memory");
    __syncthreads();
    if (threadIdx.x == 0) {
        unsigned* bar = b.bar;
        __builtin_amdgcn_s_waitcnt(0);
        unsigned nloc = b.st[0], nx = b.st[1];
        if (nloc == 0u) { xcd_barrier_complete(bar, b.x, nloc, nx); b.st[0] = nloc; b.st[1] = nx; }
        const unsigned old = xb_add(&bar[XB_XSUB(b.x)], 1u);
        const unsigned gen = old / nloc;
        if (old + 1u == (gen + 1u) * nloc) {
            __builtin_amdgcn_fence(__ATOMIC_RELEASE, "agent");
            asm volatile("s_waitcnt vmcnt(0)" ::: "memory");
            const unsigned og = xb_add(&bar[XB_TOP], 1u);
            const unsigned tg = og / nx;
            if (og + 1u == (tg + 1u) * nx) xb_add(&bar[XB_TOPGEN], 1u);
            else XB_SPIN(xb_ld(&bar[XB_TOPGEN]) == tg, bar);
            __builtin_amdgcn_fence(__ATOMIC_ACQUIRE, "agent");
            xb_add(&bar[XB_XGEN(b.x)], 1u);
            asm volatile("s_waitcnt vmcnt(0)" ::: "memory");
        } else {
            XB_SPIN(xb_ld(&bar[XB_XGEN(b.x)]) == gen, bar);
            __builtin_amdgcn_fence(__ATOMIC_ACQUIRE, "agent");
            asm volatile("s_waitcnt vmcnt(0)" ::: "memory");
        }
    }
    __syncthreads();
}
namespace cg = cooperative_groups;
constexpr int NWAVES = 8;
constexpr int DM = 1024, NB = 8, SEQ = 8192, CTX = 256, ML = NB * SEQ, MC = NB * CTX, MT = ML + MC, KVS = SEQ + CTX;
constexpr int FF = 2816, NPROJ = 2560, NMOD = 9, DEPTH = 2;
constexpr float EPS = 1e-6f, LOG2E = 1.4426950408889634f;
constexpr size_t MiB = 1u << 20;
constexpr size_t WS_MOD = 0, WS_ROPE = 1 * MiB, WS_HC = 2 * MiB, WS_CTL = 12 * MiB, CTL_BYTES = 524288, WS_XB = 800 * MiB, WS_END2 = 816 * MiB, WS_W = 16 * MiB, W_LAYER = 40 * MiB;
constexpr size_t WO_WI = 0, WO_WD = 22 * MiB, WO_WIN = 33 * MiB, WO_WO = 38 * MiB;
constexpr size_t WS_U = 96 * MiB, WS_Y = 228 * MiB, WS_OV = 360 * MiB;
constexpr size_t WS_HID = WS_OV, WS_QB = WS_OV, WS_KVB = WS_OV + 99 * MiB, WS_Z = WS_OV + 231 * MiB, WS_CB = WS_OV + 264 * MiB, WS_O = WS_OV + 297 * MiB, WS_END = WS_OV + 429 * MiB;
static_assert((size_t)MT * 768 * 2 == 99 * MiB && (size_t)MT * 1024 * 2 == 132 * MiB && (size_t)MT * 256 * 2 == 33 * MiB && (size_t)MT * FF * 2 == 363 * MiB, "map");
constexpr int RING_BYTES = 131072, LDS_BYTES = 147456, BIAS_OFF = 90112, MISC_OFF = RING_BYTES + 320, XS_OFF = RING_BYTES + 1024;

typedef unsigned short bf16;
typedef unsigned v4u __attribute__((ext_vector_type(4)));
typedef unsigned v2u __attribute__((ext_vector_type(2)));
typedef float f32x4 __attribute__((ext_vector_type(4)));
#define LDS_WAIT() asm volatile("s_waitcnt lgkmcnt(0)" ::: "memory")
__device__ __forceinline__ unsigned f2bf(float f) { unsigned u = __builtin_bit_cast(unsigned, f); return (u + 0x7fffu + ((u >> 16) & 1u)) >> 16; }
__device__ __forceinline__ unsigned pk2(float lo, float hi) { return f2bf(lo) | (f2bf(hi) << 16); }
__device__ __forceinline__ float bf2f(unsigned h) { return __builtin_bit_cast(float, h << 16); }
typedef _Float16 h16x2 __attribute__((ext_vector_type(2)));
typedef float f32x2h __attribute__((ext_vector_type(2)));
__device__ __forceinline__ unsigned pkh2(float lo, float hi) { const f32x2h v = {lo, hi}; return __builtin_bit_cast(unsigned, __builtin_convertvector(v, h16x2)); }
__device__ __forceinline__ f32x2h uph2(unsigned u) { return __builtin_convertvector(__builtin_bit_cast(h16x2, u), f32x2h); }
__device__ __forceinline__ float wave_sum(float v) {
#pragma unroll
    for (int o = 1; o < 64; o <<= 1) v += __shfl_xor(v, o);
    return v;
}
__device__ __forceinline__ int src_col(int mode, int n) {
    if (mode == 0) return n;
    if (mode == 1) { const int pn = n >> 8, bj = (n >> 7) & 1, c = n & 127; return bj * FF + 128 * pn + c; }
    const int pn = n >> 8, p = n & 255;
    if (pn == 9) return 2048 + p;
    if (pn >= 7) return ((p >> 7) ? 2304 : 1792) + 128 * (pn - 7) + (p & 127);
    const int bj = p >> 7, wc = (p >> 5) & 3, i5 = p & 31, s = 4 * pn + wc;
    const bool qk = (s < 14) || (s >= 16 && s < 22);
    const int din = qk ? (16 * ((i5 >> 2) & 1) + 4 * (i5 >> 3) + (i5 & 3)) : i5;
    return 64 * s + 32 * bj + din;
}
__device__ __forceinline__ void transpose_item(const float* W, int K, int N, bf16* WT, int mode, LAS float* scr, int item, int lane) {
    const int nblk = N / 32, kb = item / nblk, nb = item % nblk, k0 = 64 * kb, n0 = 32 * nb;
    const int sc = src_col(mode, n0 + (lane & 31));
#pragma unroll 8
    for (int i = 0; i < 32; ++i) { const int kk = 2 * i + (lane >> 5); scr[kk * 33 + (lane & 31)] = W[(size_t)(k0 + kk) * N + sc]; }
    LDS_WAIT(); asm volatile("" ::: "memory");
    const int c = lane & 7;
#pragma unroll
    for (int j = 0; j < 4; ++j) { const int n = (lane >> 3) + 8 * j; const LAS float* s = scr + (8 * c) * 33 + n;
        v4u o; o.x = pk2(s[0 * 33], s[1 * 33]); o.y = pk2(s[2 * 33], s[3 * 33]); o.z = pk2(s[4 * 33], s[5 * 33]); o.w = pk2(s[6 * 33], s[7 * 33]);
        *(GAS v4u*)(WT + (size_t)(n0 + n) * K + k0 + 8 * c) = o; }
    LDS_WAIT(); asm volatile("" ::: "memory");
}

struct Args { const float* in[14]; float* out; unsigned char* ws; };

struct EwParams { const float* hin_lat; const float* hin_ctx; float* hout_lat; float* hout_ctx; const bf16* Y; bf16* U; int nrows; int post, pre; float wres;
                  const float* mod_post; int gate_i; const float* gpost; const float* mod_pre; int shift_i; const float* gpre; bf16* Hb; int fin, hb_store; };
template <int NR> __device__ __forceinline__ void ew_rows(const EwParams& P, const int row0, const int rstride, const int lane) {
    const float* hi_[NR]; float* ho_[NR]; int mrow[NR]; f32x4 h[NR][4];
#pragma unroll
    for (int q = 0; q < NR; ++q) { const int row = row0 + q * rstride; const bool lat = row < ML; mrow[q] = lat ? (row >> 13) : 8;
        hi_[q] = lat ? P.hin_lat + (size_t)row * DM : P.hin_ctx + (size_t)(row - ML) * DM; ho_[q] = lat ? P.hout_lat + (size_t)row * DM : P.hout_ctx + (size_t)(row - ML) * DM;
#pragma unroll
        for (int j = 0; j < 4; ++j) h[q][j] = __builtin_nontemporal_load((const GAS f32x4*)hi_[q] + lane + 64 * j); }
    if (P.post) {
        f32x4 y[NR][4]; float s[NR];
#pragma unroll
        for (int q = 0; q < NR; ++q) { s[q] = 0.f;
#pragma unroll
            for (int j = 0; j < 4; ++j) { const v2u w = __builtin_nontemporal_load((const GAS v2u*)(P.Y + (size_t)(row0 + q * rstride) * DM) + lane + 64 * j);
                y[q][j] = (f32x4){bf2f(w.x & 0xffffu), bf2f(w.x >> 16), bf2f(w.y & 0xffffu), bf2f(w.y >> 16)};
                s[q] += (y[q][j].x * y[q][j].x + y[q][j].y * y[q][j].y) + (y[q][j].z * y[q][j].z + y[q][j].w * y[q][j].w); } }
#pragma unroll
        for (int q = 0; q < NR; ++q) {
            const float rstd = P.wres / sqrtf(wave_sum(s[q]) * (1.f / DM) + EPS);
            const float* gate = P.mod_post + (size_t)mrow[q] * (NMOD * DM) + P.gate_i * DM;
#pragma unroll
            for (int j = 0; j < 4; ++j) { const f32x4 g = ((const GAS f32x4*)gate)[lane + 64 * j], gp = ((const GAS f32x4*)P.gpost)[lane + 64 * j];
                h[q][j] = h[q][j] + g * (y[q][j] * rstd) * gp; }
        }
    }
#pragma unroll
    for (int q = 0; q < NR; ++q)
        if (P.post || hi_[q] != ho_[q]) {
#pragma unroll
            for (int j = 0; j < 4; ++j) ((GAS f32x4*)ho_[q])[lane + 64 * j] = h[q][j];
        }
    if (P.hb_store) {
#pragma unroll
        for (int q = 0; q < NR; ++q)
#pragma unroll
            for (int j = 0; j < 4; ++j) { v2u w; w.x = pkh2(h[q][j].x, h[q][j].y); w.y = pkh2(h[q][j].z, h[q][j].w); ((GAS v2u*)(P.Hb + (size_t)(row0 + q * rstride) * DM))[lane + 64 * j] = w; }
    }
    if (P.pre) {
#pragma unroll
        for (int q = 0; q < NR; ++q) {
            float s = 0.f;
#pragma unroll
            for (int j = 0; j < 4; ++j) s += (h[q][j].x * h[q][j].x + h[q][j].y * h[q][j].y) + (h[q][j].z * h[q][j].z + h[q][j].w * h[q][j].w);
            const float rstd = 1.f / sqrtf(wave_sum(s) * (1.f / DM) + EPS);
            const float* shift = P.mod_pre + (size_t)mrow[q] * (NMOD * DM) + P.shift_i * DM; const float* scale = shift + DM;
#pragma unroll
            for (int j = 0; j < 4; ++j) { const f32x4 sh = ((const GAS f32x4*)shift)[lane + 64 * j], sc = ((const GAS f32x4*)scale)[lane + 64 * j], gp = ((const GAS f32x4*)P.gpre)[lane + 64 * j];
                const f32x4 u = (h[q][j] * rstd) * gp * (sc + 1.0f) + sh;
                v2u w; w.x = pk2(u.x, u.y); w.y = pk2(u.z, u.w);
                ((GAS v2u*)(P.U + (size_t)(row0 + q * rstride) * DM))[lane + 64 * j] = w; }
        }
    }
}
__device__ __forceinline__ void ew_pass(const EwParams& P, int gw, int NGW, int lane) {
    int row = gw;
    for (; row + NGW < P.nrows; row += 2 * NGW) ew_rows<2>(P, row, NGW, lane);
    if (row < P.nrows) ew_rows<1>(P, row, 0, lane);
}

struct PanelOrder {
    int nwg, G, v;
    __device__ __forceinline__ void init(int M, int G_, int bid) { nwg = (M / 256) * 4; G = G_; v = (G_ % 8 == 0) ? (bid % 8) * (G_ / 8) + bid / 8 : bid; }
    __device__ __forceinline__ bool next(int i, pg8::Unit& u) const { long L = (long)i * G + v;
        if (G == 256 && nwg == 1056 && i >= 4) { if (i > 4 || (v & 31) >= 4) return false; L = 1024 + 4 * (v >> 5) + (v & 31); }
        if (L >= nwg) return false; u.pm = (int)(L >> 2); u.pn = (int)(L & 3); return true; }
    __device__ __forceinline__ void a_ready(const pg8::Unit&) const {}
    __device__ __forceinline__ void done(const pg8::Unit&) const {}
};
struct SkewOrder : pg8::StaticOrder {
    int k, late, wgm; const unsigned* dcnt;
    __device__ __forceinline__ void init2(int M, int N, int G_, int c_, int k_, const unsigned* done_) { init(M, N, G_, c_); wgm = pg8::WGM; dcnt = done_; k = (G_ == 256 && k_ > 0) ? k_ : (1 << 20); late = ((c_ >> 3) < 4); }
    __device__ __forceinline__ bool next(int i, pg8::Unit& u) const {
        const int x = c & 7, j = c >> 3, per = G >> 3, q = nwg >> 3;
        const int off = (i < k) ? i * per + j : k * per + (i - k) * (per - 4) + (j - 4);
        if ((i >= k && late) || off >= q) return false;
        const int wgid = x * q + off;
        const int nig = wgm * nN, gid = wgid / nig, fm = gid * wgm, gsz = (nM - fm) < wgm ? (nM - fm) : wgm;
        u.pm = fm + ((wgid % nig) % gsz); u.pn = (wgid % nig) / gsz; return true;
    }
    __device__ __forceinline__ void a_ready(const pg8::Unit& u) const {
        if (dcnt != nullptr && u.pm >= 256) {
            if (threadIdx.x < 64) { unsigned spins = 0;
                while ((unsigned)__builtin_amdgcn_readfirstlane(__hip_atomic_load(dcnt + 16 * (u.pm - 256), __ATOMIC_RELAXED, __HIP_MEMORY_SCOPE_AGENT)) < 4u) { __builtin_amdgcn_s_sleep(2); if (++spins > (1u << 22)) break; }
                __builtin_amdgcn_fence(__ATOMIC_ACQUIRE, "agent");
                asm volatile("s_waitcnt vmcnt(0)" ::: "memory"); }
            asm volatile("" ::: "memory"); __builtin_amdgcn_s_barrier(); asm volatile("" ::: "memory");
        }
    }
};
struct RowStats {
    float* xbuf; unsigned* cnt;
    __device__ __forceinline__ void run(const pg8::f32x4 (&v)[2][2][4][2], const pg8::Unit& u, int wr, int wc, int fr, int fq, LAS unsigned char* sl, int wid, int lane) const {
        LAS float* Pp = (LAS float*)sl; LAS float* S = (LAS float*)(sl + 4096);
#pragma unroll
        for (int ai = 0; ai < 2; ++ai)
#pragma unroll
            for (int m = 0; m < 4; ++m) { float q = 0.f;
#pragma unroll
                for (int bj = 0; bj < 2; ++bj)
#pragma unroll
                    for (int n = 0; n < 2; ++n) { const pg8::f32x4 d = v[ai][bj][m][n]; q += (d[0] * d[0] + d[1] * d[1]) + (d[2] * d[2] + d[3] * d[3]); }
                q += __shfl_xor(q, 16); q += __shfl_xor(q, 32);
                if (fq == 0) Pp[(ai * 128 + wr * 64 + m * 16 + fr) * 4 + wc] = q; }
        asm volatile("s_waitcnt lgkmcnt(0)" ::: "memory"); __builtin_amdgcn_s_barrier(); asm volatile("" ::: "memory");
        const int row = wid * 32 + (lane & 31);
        if (lane < 32) { const float s = (Pp[row * 4 + 0] + Pp[row * 4 + 1]) + (Pp[row * 4 + 2] + Pp[row * 4 + 3]);
            __hip_atomic_store(xbuf + ((size_t)(u.pm * 256 + row) * 4 + u.pn), s, __ATOMIC_RELAXED, __HIP_MEMORY_SCOPE_AGENT); }
        asm volatile("s_waitcnt vmcnt(0)" ::: "memory");
        if (lane == 0) __hip_atomic_fetch_add(cnt + 16 * u.pm, 1u, __ATOMIC_RELAXED, __HIP_MEMORY_SCOPE_AGENT);
        if (wid == 0) { unsigned spins = 0;
            while ((unsigned)__builtin_amdgcn_readfirstlane(__hip_atomic_load(cnt + 16 * u.pm, __ATOMIC_RELAXED, __HIP_MEMORY_SCOPE_AGENT)) < 32u) { __builtin_amdgcn_s_sleep(1); if (++spins > (1u << 22)) break; } }
        asm volatile("s_waitcnt vmcnt(0) lgkmcnt(0)" ::: "memory"); __builtin_amdgcn_s_barrier(); asm volatile("" ::: "memory");
        if (lane < 32) { const float* slot = xbuf + (size_t)(u.pm * 256 + row) * 4; float s = 0.f;
#pragma unroll
            for (int t = 0; t < 4; ++t) s += __hip_atomic_load(slot + t, __ATOMIC_RELAXED, __HIP_MEMORY_SCOPE_AGENT);
            S[row] = s; }
        asm volatile("s_waitcnt lgkmcnt(0)" ::: "memory"); __builtin_amdgcn_s_barrier(); asm volatile("" ::: "memory");
    }
};
struct EpiRmsResPre {
    static constexpr int NPRE = 6;
    static constexpr bool PERM = true, AFTER_DRAIN = false;
    EwParams P; RowStats st1, st2; LAS unsigned char* sl; int skew; int G; XcdBarrier xb; unsigned* done;
    __device__ __forceinline__ void operator()(pg8::f32x4 (&acc)[2][2][4][2], const pg8::Unit& u, int wr, int wc, int fr, int fq) const {
        asm volatile("" : "+v"(fr), "+v"(fq));
        const int wid = wr * 4 + wc, lane = fq * 16 + fr, pm = u.pm;
        const LAS float* S = (const LAS float*)(sl + 4096);
        const bool lat = pm < 256; const int mrow = lat ? (pm >> 5) : 8;
        const int col0 = u.pn * 256 + wc * 32 + 8 * fq;
        bf16* hb = P.Hb + (size_t)(pm * 256 + wr * 64 + fr) * DM + col0;
        float* fout = P.hout_lat + (size_t)(pm * 256 + wr * 64 + fr) * DM + col0;
        pg8::u32x4 pre[NPRE][2];
#pragma unroll
        for (int m = 0; m < NPRE; ++m)
#pragma unroll
            for (int bj = 0; bj < 2; ++bj) pre[m][bj] = *(const pg8::u32x4*)(hb + (size_t)((m >> 2) * 128 + (m & 3) * 16) * DM + bj * 128);
        st1.run(acc, u, wr, wc, fr, fq, sl, wid, lane);
        {
            const float* gate = P.mod_post + (size_t)mrow * (NMOD * DM) + P.gate_i * DM + col0; const float* gpost = P.gpost + col0;
#pragma unroll
            for (int ai = 0; ai < 2; ++ai)
#pragma unroll
                for (int m = 0; m < 4; ++m) { const int r = ai * 128 + m * 16; const float rstd = P.wres / sqrtf(S[r + wr * 64 + fr] * (1.f / DM) + EPS);
#pragma unroll
                    for (int bj = 0; bj < 2; ++bj) { const pg8::u32x4 hw = (ai * 4 + m < NPRE) ? pre[ai * 4 + m < NPRE ? ai * 4 + m : 0][bj] : *(const pg8::u32x4*)(hb + (size_t)r * DM + bj * 128);
                        const f32x2h ha = uph2(hw.x), hbv = uph2(hw.y), hc = uph2(hw.z), hd = uph2(hw.w); const pg8::f32x4 h0 = {ha.x, ha.y, hbv.x, hbv.y}, h1 = {hc.x, hc.y, hd.x, hd.y};
                        const pg8::f32x4 g0 = *(const pg8::f32x4*)(gate + bj * 128) * *(const pg8::f32x4*)(gpost + bj * 128), g1 = *(const pg8::f32x4*)(gate + bj * 128 + 4) * *(const pg8::f32x4*)(gpost + bj * 128 + 4);
                        acc[ai][bj][m][0] = h0 + g0 * (acc[ai][bj][m][0] * rstd); acc[ai][bj][m][1] = h1 + g1 * (acc[ai][bj][m][1] * rstd); }
                    asm volatile("" : "+v"(acc[ai][0][m][0]), "+v"(acc[ai][0][m][1]), "+v"(acc[ai][1][m][0]), "+v"(acc[ai][1][m][1]));
                    if (m & 1) asm volatile("" ::: "memory"); }
        }
        if (P.pre) st2.run(acc, u, wr, wc, fr, fq, sl, wid, lane);
        const float* shift = P.mod_pre + (size_t)mrow * (NMOD * DM) + P.shift_i * DM + col0; const float* scale = shift + DM; const float* gpre = P.gpre + col0;
        bf16* up = P.U + (size_t)pm * 256 * DM + (size_t)(wr * 64 + fr) * DM + col0;
#pragma unroll
        for (int ai = 0; ai < 2; ++ai)
#pragma unroll
            for (int m = 0; m < 4; ++m) { const int r = ai * 128 + m * 16; const float rstd = 1.f / sqrtf(S[r + wr * 64 + fr] * (1.f / DM) + EPS);
#pragma unroll
                for (int bj = 0; bj < 2; ++bj) {
                    const pg8::f32x4 x0 = acc[ai][bj][m][0], x1 = acc[ai][bj][m][1];
                    if (P.fin) { *(pg8::f32x4*)(fout + (size_t)r * DM + bj * 128) = x0; *(pg8::f32x4*)(fout + (size_t)r * DM + bj * 128 + 4) = x1; }
                    else { pg8::u32x4 w; w.x = pkh2(x0[0], x0[1]); w.y = pkh2(x0[2], x0[3]); w.z = pkh2(x1[0], x1[1]); w.w = pkh2(x1[2], x1[3]); *(pg8::u32x4*)(hb + (size_t)r * DM + bj * 128) = w; }
                    if (P.pre) { const pg8::f32x4 o0 = (x0 * rstd) * (*(const pg8::f32x4*)(gpre + bj * 128) * (*(const pg8::f32x4*)(scale + bj * 128) + 1.0f)) + *(const pg8::f32x4*)(shift + bj * 128),
                                               o1 = (x1 * rstd) * (*(const pg8::f32x4*)(gpre + bj * 128 + 4) * (*(const pg8::f32x4*)(scale + bj * 128 + 4) + 1.0f)) + *(const pg8::f32x4*)(shift + bj * 128 + 4);
                        *(pg8::u32x4*)(up + (size_t)r * DM + bj * 128) = pg8::pack8(o0, o1); } }
                asm volatile("" ::: "memory"); }
        if (skew) {
            const int L = 4 * pm + u.pn;
            if (pm >= 256) {
                asm volatile("s_waitcnt vmcnt(0)" ::: "memory");
                asm volatile("" ::: "memory"); __builtin_amdgcn_s_barrier(); asm volatile("" ::: "memory");
                if (wid == 0 && lane == 0) { __builtin_amdgcn_fence(__ATOMIC_RELEASE, "agent"); asm volatile("s_waitcnt vmcnt(0)" ::: "memory");
                    __hip_atomic_fetch_add(done + 16 * (pm - 256), 1u, __ATOMIC_RELAXED, __HIP_MEMORY_SCOPE_AGENT); }
            } else if (L >= 768 && ((L - 768) & 31) < 4) {
                xcd_barrier(xb);
            }
        }
    }
};

__global__ void __launch_bounds__(NWAVES * 64, 2) fwd_mega(Args args) {
    extern __shared__ __attribute__((aligned(16))) unsigned char lds[];
    cg::grid_group grid = cg::this_grid();
    LAS unsigned char* ldsL = (LAS unsigned char*)lds;
    for (int u_ = threadIdx.x; u_ < (LDS_BYTES - RING_BYTES) / 4; u_ += NWAVES * 64) ((LAS unsigned*)(ldsL + RING_BYTES))[u_] = 0u;
    __syncthreads();
    const XcdBarrier xbar = xcd_barrier_post((unsigned*)(((const __attribute__((address_space(4))) Args*)__builtin_amdgcn_kernarg_segment_ptr())->ws + WS_CTL), (volatile LAS unsigned*)(ldsL + MISC_OFF) + 8);
#ifdef PROBE_GEMM2
#define PROBE_G2X for (int rep_ = 0; rep_ < 2; ++rep_)
#else
#define PROBE_G2X
#endif
#ifdef ALIGN_OFF
#define PG_ALIGN false
#else
#define PG_ALIGN true
#endif
#ifndef IN_WGM
#define IN_WGM 8
#endif
#ifndef SW_WGM
#define SW_WGM 8
#endif
#ifndef SKEW_ALL
#define SKEW_ALL 1
#endif
#ifndef SKEW_ON
#define SKEW_ON 1
#endif
#ifdef USE_CG_SYNC
#define GSYNC() grid.sync()
#else
#define GSYNC() xcd_barrier(xbar)
#endif
    const int tid = threadIdx.x, lane = tid & 63, wave = __builtin_amdgcn_readfirstlane(tid >> 6);
    const int G = gridDim.x, bid = blockIdx.x;
    const int gw = bid * NWAVES + wave, NGW = G * NWAVES;
    typedef const __attribute__((address_space(4))) Args* kargs_t;
#define KARGS() ({ kargs_t p_ = (kargs_t)__builtin_amdgcn_kernarg_segment_ptr(); asm volatile("" : "+s"(p_)); p_; })
#define IN_(i) ((const float*)KARGS()->in[i])
#define WS_() ((unsigned char*)KARGS()->ws)
#define p_x IN_(0)
#define p_c_in IN_(1)
#define p_ctx IN_(2)
#define p_c_ctx IN_(3)
#define p_w_ada IN_(4)
#define p_b_ada IN_(5)
#define p_norm_g IN_(6)
#define p_w_in IN_(7)
#define p_qk_g IN_(8)
#define p_rpb IN_(9)
#define p_conv_w IN_(10)
#define p_w_o IN_(11)
#define p_ffn_wi IN_(12)
#define p_ffn_wo IN_(13)
#define p_ws WS_()
#define p_MOD ((float*)(WS_() + WS_MOD))
#define p_ROPEC ((float*)(WS_() + WS_ROPE))
#define p_ROPES (p_ROPEC + 128 * 16)
#define p_HC ((float*)(WS_() + WS_HC))
#define p_U ((bf16*)(WS_() + WS_U))
#define p_Y ((bf16*)(WS_() + WS_Y))
#define p_HID ((bf16*)(WS_() + WS_HID))
#define p_QB ((bf16*)(WS_() + WS_QB))
#define p_KVB ((bf16*)(WS_() + WS_KVB))
#define p_Z ((bf16*)(WS_() + WS_Z))
#define p_CB ((bf16*)(WS_() + WS_CB))
#define p_O ((bf16*)(WS_() + WS_O))
#define p_H ((float*)KARGS()->out)
#ifdef PROBE_P02
    for (int rep_ = 0; rep_ < 2; ++rep_)
#endif
    {
        LAS float* scr = (LAS float*)(ldsL + wave * 16384);
        constexpr int I_WI = (DM / 64) * (2 * FF / 32), I_WD = (FF / 64) * (DM / 32), I_WIN = (DM / 64) * (NPROJ / 32), I_WO = (DM / 64) * (DM / 32);
        constexpr int I_LAYER = 2 * I_WI + 2 * I_WD + I_WIN + I_WO;
        for (int it = gw; it < DEPTH * I_LAYER; it += NGW) {
            const int L = it / I_LAYER; int r = it % I_LAYER; unsigned char* wl = p_ws + WS_W + L * W_LAYER;
            if (r < 2 * I_WI) { const int k = r / I_WI; transpose_item(p_ffn_wi + (size_t)(L * 2 + k) * DM * 2 * FF, DM, 2 * FF, (bf16*)(wl + WO_WI) + (size_t)k * 2 * FF * DM, 1, scr, r % I_WI, lane); continue; } r -= 2 * I_WI;
            if (r < 2 * I_WD) { const int k = r / I_WD; transpose_item(p_ffn_wo + (size_t)(L * 2 + k) * FF * DM, FF, DM, (bf16*)(wl + WO_WD) + (size_t)k * DM * FF, 0, scr, r % I_WD, lane); continue; } r -= 2 * I_WD;
            if (r < I_WIN) { transpose_item(p_w_in + (size_t)L * DM * NPROJ, DM, NPROJ, (bf16*)(wl + WO_WIN), 2, scr, r, lane); continue; } r -= I_WIN;
            transpose_item(p_w_o + (size_t)L * DM * DM, DM, DM, (bf16*)(wl + WO_WO), 0, scr, r, lane);
        }
        __syncthreads();
        LAS float* sc = (LAS float*)ldsL;
        LAS float* part = (LAS float*)(ldsL + 40960);
        const float* cinp = p_c_in; const float* cctxp = p_c_ctx;
        for (int i = tid; i < 9 * DM; i += NWAVES * 64) { const float v = (i < 8 * DM) ? cinp[i] : cctxp[i - 8 * DM]; sc[i] = v / (1.0f + __expf(-v)); }
        __syncthreads();
        float* MODp = p_MOD; const float* badap = p_b_ada; const float* wadap = p_w_ada;
        for (int it = bid; it < DEPTH * (NMOD * DM / 64); it += G) {
            const int L = it / (NMOD * DM / 64), n0 = (it % (NMOD * DM / 64)) * 64;
            const float* wp = wadap + (size_t)L * DM * (NMOD * DM) + (size_t)(wave * 128) * (NMOD * DM) + n0 + lane;
            float a[9];
#pragma unroll
            for (int r = 0; r < 9; ++r) a[r] = 0.f;
#pragma unroll 8
            for (int k = 0; k < 128; ++k) { const float wv = wp[(size_t)k * (NMOD * DM)];
#pragma unroll
                for (int r = 0; r < 9; ++r) a[r] += sc[r * DM + wave * 128 + k] * wv; }
#pragma unroll
            for (int r = 0; r < 9; ++r) part[(wave * 9 + r) * 64 + lane] = a[r];
            __syncthreads();
            for (int i = tid; i < 9 * 64; i += NWAVES * 64) { float s = 0.f;
#pragma unroll
                for (int w = 0; w < 8; ++w) s += part[w * 576 + i];
                const int r = i >> 6, n = n0 + (i & 63);
                MODp[((size_t)L * 9 + r) * (NMOD * DM) + n] = s + badap[(size_t)L * NMOD * DM + n]; }
            __syncthreads();
        }
        for (int i = bid * (NWAVES * 64) + tid; i < 128 * 16; i += G * NWAVES * 64) { const int pos = i >> 4, f = i & 15;
            const float freq = 1.0f / powf(10000.0f, (float)f / 16.0f); const float ang = (float)pos * freq; float* rc_ = p_ROPEC; rc_[i] = cosf(ang); rc_[i + 2048] = sinf(ang); }
    }
    grid.sync();
    {
        EwParams P; P.hin_lat = p_x; P.hin_ctx = p_ctx; P.hout_lat = (float*)P.hin_lat; P.hout_ctx = (float*)P.hin_ctx; P.Y = p_Y; P.U = p_U; P.nrows = MT; P.post = 0; P.pre = 1; P.wres = 0.f; P.Hb = p_Y; P.fin = 0; P.hb_store = 1;
        P.mod_post = p_MOD; P.gate_i = 0; P.gpost = p_norm_g; P.mod_pre = p_MOD; P.shift_i = 0; P.gpre = p_norm_g;
        ew_pass(P, gw, NGW, lane);
    }
    GSYNC();

    for (int L = 0; L < DEPTH; ++L) {
        const bool last = (L == DEPTH - 1);
#define wl (p_ws + WS_W + L * W_LAYER)
#define MODL (p_MOD + (size_t)L * 9 * NMOD * DM)
#define gL (p_norm_g + (size_t)L * 6 * DM)
        for (int sg = 0; sg < 3; ++sg) {
            bool did_bar = false;
            int tid = threadIdx.x; asm volatile("" : "+v"(tid)); const int lane = tid & 63, wave = __builtin_amdgcn_readfirstlane(tid >> 6), gw = bid * NWAVES + wave;
            const int Mrows = (last && sg >= 1) ? ML : MT;
            if (sg != 1) {
                pg8::Gemm g{p_U, (const bf16*)(wl + WO_WI) + (size_t)(sg >> 1) * 2 * FF * DM, Mrows, 2 * FF, DM}; SkewOrder S; { const bool sk = SKEW_ON && SKEW_ALL && ((L == 0 && sg == 2) || (L == 1 && sg == 0)); const int pbank = (sg == 2) ? L * 3 + 1 : (L - 1) * 3 + 2;
                    S.init2(Mrows, 2 * FF, G, bid, sk ? SKEW_K1 : 0, sk ? (const unsigned*)(p_ws + WS_CTL + 409600) + (size_t)pbank * 128 : nullptr); S.wgm = SW_WGM; }
                pg8::EpiSwiglu E{p_HID, FF};
#ifndef NO_GSW
                PROBE_G2X pg8::gemm_phase<pg8::EpiSwiglu, SkewOrder, PG_ALIGN, true>(ldsL, g, S, E);
#endif
                GSYNC();
            } else {
                {
                    pg8::Gemm g{p_U, (const bf16*)(wl + WO_WIN), MT, NPROJ, DM}; SkewOrder S; S.init2(MT, NPROJ, G, bid, SKEW_ON ? SKEW_K3 : 0, (const unsigned*)(p_ws + WS_CTL + 409600) + (size_t)(L * 3 + 0) * 128); S.wgm = IN_WGM;
                    pg8::EpiInProj E{p_QB, p_KVB, p_Z, p_CB, p_qk_g + (size_t)L * 128, p_ROPEC, p_ROPES};
#ifndef NO_GIN
                    PROBE_G2X pg8::gemm_phase<pg8::EpiInProj, SkewOrder, PG_ALIGN, true>(ldsL, g, S, E);
#endif
                }
                GSYNC();
#ifdef PROBE_ATT2
                for (int rep_ = 0; rep_ < 2; ++rep_)
#endif
                {
                    using attn_body::AttnJob;
                    const int nA = NB * 6 * 32, nC = last ? 0 : NB * 12;
                    for (int w = bid; w < nA + nC; w += G) {
                        AttnJob J; J.qp = 768; J.kvp = 1024; J.op = 1024; J.seg1 = 0; J.r0 = 0; J.lo = 0; J.biasL = (attn_body::lds_cfptr)(ldsL + BIAS_OFF);
                        if (w < nA) {
                            int grp, h3, qb;
                            if (G == 256) { const int i = w >> 8, xx = bid & 7, v = bid >> 3; grp = 2 * xx + i / 3; h3 = i % 3; qb = v; }
                            else { grp = w / 96; const int rem = w % 96; h3 = rem >> 5; qb = rem & 31; }
                            const int b = grp >> 1, kvh = grp & 1, hq = kvh * 3 + h3;
                            J.Q0 = (const attn_body::bf16*)(p_QB + (size_t)(b * SEQ + qb * 256) * 768 + 64 * hq);
                            J.K0 = (const attn_body::bf16*)(p_KVB + (size_t)(b * KVS) * 1024 + 64 * kvh);
                            J.V0 = (const attn_body::bf16*)(p_KVB + (size_t)(b * KVS) * 1024 + 128 + 64 * kvh);
                            J.O0 = (attn_body::bf16*)(p_O + (size_t)(b * SEQ + qb * 256) * 1024 + 64 * hq);
                            J.NT = KVS / 64; J.nt0 = KVS / 64;
                        } else {
                            const int ci = w - nA, b = ci / 12, hh = ci % 12;
                            const int qcol = (hh < 6) ? 64 * hh : 384 + 64 * (hh - 6), kcol = (hh < 6) ? 64 * (hh / 3) : 256 + 64 * (hh - 6), vcol = (hh < 6) ? 128 + 64 * (hh / 3) : 640 + 64 * (hh - 6);
                            J.Q0 = (const attn_body::bf16*)(p_QB + (size_t)(ML + b * CTX) * 768 + qcol);
                            J.K0 = (const attn_body::bf16*)(p_KVB + (size_t)(b * KVS + SEQ) * 1024 + kcol);
                            J.V0 = (const attn_body::bf16*)(p_KVB + (size_t)(b * KVS + SEQ) * 1024 + vcol);
                            J.O0 = (attn_body::bf16*)(p_O + (size_t)(ML + b * CTX) * 1024 + qcol);
                            J.NT = 4; J.nt0 = 4;
                        }
#ifndef NO_ATT0
                        attn_body::attn_unit<8, 0>(J, (char*)lds);
#endif
                    }
                    LAS float* biasT = (LAS float*)(ldsL + BIAS_OFF); const float* rpbp = p_rpb;
                    for (int w = bid; w < NB * 6 * 32; w += G) {
                        const int b = w / 192, h = (w >> 5) % 6, rb = w & 31, r0 = 4 * rb, lo = min(max(r0 - 4, 0), 116);
                        for (int i = tid; i < 15 * 31; i += NWAVES * 64) biasT[i] = rpbp[((size_t)L * 6 + h) * 465 + i] * LOG2E;
                        AttnJob J; J.qp = 768; J.kvp = 1024; J.op = 1024; J.biasL = (attn_body::lds_cfptr)biasT; J.r0 = r0; J.lo = lo;
                        J.Q0 = (const attn_body::bf16*)(p_QB + (size_t)(b * SEQ + rb * 256) * 768 + 384 + 64 * h);
                        J.K0 = (const attn_body::bf16*)(p_KVB + (size_t)(b * KVS + SEQ) * 1024 + 256 + 64 * h);
                        J.V0 = (const attn_body::bf16*)(p_KVB + (size_t)(b * KVS + SEQ) * 1024 + 640 + 64 * h);
                        J.O0 = (attn_body::bf16*)(p_O + (size_t)(b * SEQ + rb * 256) * 1024 + 384 + 64 * h);
                        J.NT = 16; J.nt0 = 4; J.seg1 = 64 * lo - SEQ;
#ifndef NO_ATT1
                        attn_body::attn_unit<8, 1>(J, (char*)lds);
#endif
                    }
                    const float* cw = p_conv_w + (size_t)L * 3 * 256; const bf16* Zp = p_Z; const bf16* CBp = p_CB; bf16* Op = p_O;
                    const int nrow = last ? ML : MT;
                    for (int idx = bid * (NWAVES * 64) + tid; idx < nrow * 32; idx += G * NWAVES * 64) {
                        const int row = idx >> 5, c8 = (idx & 31) * 8;
                        const int t = (row < ML) ? (row & (SEQ - 1)) : ((row - ML) & (CTX - 1)); const int tl = (row < ML) ? SEQ - 1 : CTX - 1;
                        const v4u zc = *(const GAS v4u*)(Zp + (size_t)row * 256 + c8);
                        v4u zp = {0u, 0u, 0u, 0u}, zn = {0u, 0u, 0u, 0u};
                        if (t > 0) zp = *(const GAS v4u*)(Zp + (size_t)(row - 1) * 256 + c8);
                        if (t < tl) zn = *(const GAS v4u*)(Zp + (size_t)(row + 1) * 256 + c8);
                        const v4u cb = *(const GAS v4u*)(CBp + (size_t)row * 256 + c8);
                        v4u o;
#pragma unroll
                        for (int q = 0; q < 4; ++q) {
                            const int ch = c8 + 2 * q;
                            const float y0 = cw[ch] * bf2f(zp[q] & 0xffffu) + cw[256 + ch] * bf2f(zc[q] & 0xffffu) + cw[512 + ch] * bf2f(zn[q] & 0xffffu);
                            const float y1 = cw[ch + 1] * bf2f(zp[q] >> 16) + cw[256 + ch + 1] * bf2f(zc[q] >> 16) + cw[512 + ch + 1] * bf2f(zn[q] >> 16);
                            o[q] = pk2(bf2f(cb[q] & 0xffffu) * y0, bf2f(cb[q] >> 16) * y1);
                        }
                        *(GAS v4u*)(Op + (size_t)row * 1024 + 768 + c8) = o;
                    }
                }
                GSYNC();
            }
            {
                const bool fin = last && sg == 2;
                const int nL = (sg == 2) ? L + 1 : L, nsg = (sg == 2) ? 0 : sg + 1;
                EwParams P; P.hout_lat = p_H; P.hout_ctx = p_HC; P.hin_lat = P.hout_lat; P.hin_ctx = P.hout_ctx; P.Y = p_Y; P.U = p_U; P.Hb = p_Y; P.fin = fin ? 1 : 0; P.hb_store = 0; P.nrows = Mrows; P.post = 1; P.pre = fin ? 0 : 1; P.wres = (sg == 1) ? 1.0f : 0.5f;
                P.mod_post = MODL; P.gate_i = 3 * sg + 2; P.gpost = gL + (2 * sg + 1) * DM;
                P.mod_pre = fin ? P.mod_post : p_MOD + (size_t)nL * 9 * NMOD * DM; P.shift_i = 3 * nsg; P.gpre = fin ? P.gpost : p_norm_g + ((size_t)nL * 6 + 2 * nsg) * DM;
                const bf16* A = (sg == 1) ? p_O : p_HID; const int K = (sg == 1) ? DM : FF;
                const bf16* Bt = (sg == 1) ? (const bf16*)(wl + WO_WO) : (const bf16*)(wl + WO_WD) + (size_t)(sg >> 1) * DM * FF;
                pg8::Gemm g{A, Bt, Mrows, DM, K}; PanelOrder S; S.init(Mrows, G, bid);
                const int bank = L * 3 + sg;
                unsigned* cbase = (unsigned*)(p_ws + WS_CTL + 65536) + (size_t)bank * 2 * (264 * 16);
                float* xb = (float*)(p_ws + WS_XB) + (size_t)bank * 2 * ((size_t)MT * 4);
                const int skew = (SKEW_ON && G == 256 && Mrows == MT && (SKEW_ALL || sg == 0)) ? 1 : 0;
                unsigned* dn = (unsigned*)(p_ws + WS_CTL + 409600) + (size_t)bank * 128;
                did_bar = skew && ((S.v & 31) < 4);
                EpiRmsResPre E{P, RowStats{xb, cbase}, RowStats{xb + (size_t)MT * 4, cbase + 264 * 16}, ldsL + XS_OFF, skew, G, xbar, dn};
#ifndef NO_GST
                PROBE_G2X pg8::gemm_phase<EpiRmsResPre, PanelOrder, true, true>(ldsL, g, S, E);
#endif
            }
            if (!(last && sg == 2) && !did_bar) GSYNC();
        }
    }
}

extern "C" void kernel_launch(void* const* d_in, const int* in_sizes, int n_in, void* d_out, int out_size, void* d_ws, size_t ws_size, hipStream_t stream) {
    static int grid = 0;
    if (grid == 0) {
        if (n_in != 14 || out_size != ML * DM || ws_size < WS_END2) { fprintf(stderr, "kernel_launch: unexpected shapes (n_in %d out %d ws %zu)\n", n_in, out_size, ws_size); grid = -1; return; }
        int dev = 0, cus = 0, per_cu = 0;
        if (hipGetDevice(&dev) != hipSuccess || hipDeviceGetAttribute(&cus, hipDeviceAttributeMultiprocessorCount, dev) != hipSuccess) { grid = -1; return; }
        if (hipFuncSetAttribute((const void*)fwd_mega, hipFuncAttributeMaxDynamicSharedMemorySize, LDS_BYTES) != hipSuccess) { fprintf(stderr, "kernel_launch: hipFuncSetAttribute failed\n"); grid = -1; return; }
        if (hipOccupancyMaxActiveBlocksPerMultiprocessor(&per_cu, (const void*)fwd_mega, NWAVES * 64, LDS_BYTES) != hipSuccess || per_cu < 1) per_cu = 1;
        (void)hipGetLastError();
        grid = cus * per_cu;
        fprintf(stderr, "kernel_launch: grid %d (cus %d x %d)\n", grid, cus, per_cu);
    }
    if (grid < 0) return;
    if (hipMemsetAsync((char*)d_ws + WS_CTL, 0, CTL_BYTES, stream) != hipSuccess) { fprintf(stderr, "kernel_launch: memset failed\n"); return; }
    Args a{};
    for (int i = 0; i < 14; ++i) a.in[i] = (const float*)d_in[i];
    a.out = (float*)d_out; a.ws = (unsigned char*)d_ws;
    void* kargs[] = {&a};
    const hipError_t e = hipLaunchCooperativeKernel((const void*)fwd_mega, dim3(grid), dim3(NWAVES * 64), kargs, LDS_BYTES, stream);
    if (e != hipSuccess) fprintf(stderr, "kernel_launch: cooperative launch failed: %s (grid %d)\n", hipGetErrorString(e), grid);
}
```

```cpp
#define SKEW_K3 8
#define SKEW_K1 21
#define SW_WGM 4
#include <hip/hip_runtime.h>
#include <hip/hip_cooperative_groups.h>
#include <cstdio>
#include <cstdint>
namespace pg8 {
#define PG8_LAS __attribute__((address_space(3)))
typedef unsigned short bf16_t;
typedef short bf16x8 __attribute__((ext_vector_type(8)));
typedef float f32x4 __attribute__((ext_vector_type(4)));
typedef unsigned u32x4 __attribute__((ext_vector_type(4)));
constexpr int BM = 256, BK = 64, HALF = 128, HTB = HALF * BK * 2  , STAGE_BYTES = 8 * HTB, NXCD = 8, WGM = 8;

__host__ __device__ __forceinline__ int lds_byte(int r, int c) { const int st = (r >> 4) * 2 + (c >> 5), rr = r & 15, cc = c & 31, ob = rr * 64 + cc * 2; return st * 1024 + (ob ^ (((ob >> 9) & 1) << 5)); }
__host__ __device__ __forceinline__ void stage_rc(int b, int& R, int& C) { const int st = b / 1024, sb = b % 1024, swz = sb ^ (((sb >> 9) & 1) << 5); R = (st >> 1) * 16 + swz / 64; C = (st & 1) * 32 + (swz % 64) / 2; }
__host__ __device__ __forceinline__ int perm32(int rho) { const int n = rho >> 4, i = rho & 15; return 8 * (i >> 2) + 4 * n + (i & 3); }

struct Unit { int pm, pn; };
struct Gemm { const bf16_t* A; const bf16_t* Bt; int M, N, K; };

struct StaticOrder {
    int nM, nN, nwg, G, c;
    __host__ __device__ void init(int M, int N, int G_, int c_) { nM = M / BM; nN = N / BM; nwg = nM * nN; G = G_; c = c_; }
    __host__ __device__ bool next(int i, Unit& u) const {
        const long L = (long)i * G + c; if (L >= nwg) return false;
        int wgid = (int)L; { const int q = nwg / NXCD, r = nwg % NXCD, xcd = wgid % NXCD, off = wgid / NXCD; wgid = (xcd < r ? xcd * (q + 1) : r * (q + 1) + (xcd - r) * q) + off; }
        const int nig = WGM * nN, gid = wgid / nig, fm = gid * WGM, gsz = (nM - fm) < WGM ? (nM - fm) : WGM;
        u.pm = fm + ((wgid % nig) % gsz); u.pn = (wgid % nig) / gsz; return true;
    }
    __device__ __forceinline__ void a_ready(const Unit&) const {}
    __device__ __forceinline__ void done(const Unit&) const {}
};

__device__ __forceinline__ unsigned cvt_pk_bf16(float lo, float hi) { unsigned r; asm volatile("v_cvt_pk_bf16_f32 %0, %1, %2" : "=v"(r) : "v"(lo), "v"(hi)); return r; }
typedef float f32x2 __attribute__((ext_vector_type(2)));
typedef float f32x2 __attribute__((ext_vector_type(2)));
__device__ __forceinline__ u32x4 pack8(const f32x4 v0, const f32x4 v1) { u32x4 w; w.x = cvt_pk_bf16(v0[0], v0[1]); w.y = cvt_pk_bf16(v0[2], v0[3]); w.z = cvt_pk_bf16(v1[0], v1[1]); w.w = cvt_pk_bf16(v1[2], v1[3]); return w; }

struct EpiStore {
    static constexpr bool PERM = true, AFTER_DRAIN = false;
    bf16_t* O; int ldc;
    __device__ __forceinline__ void operator()(const f32x4 (&acc)[2][2][4][2], const Unit& u, int wr, int wc, int fr, int fq) const {
        asm volatile("" : "+v"(fr), "+v"(fq));
        bf16_t* base = O + (size_t)(u.pm * BM + wr * 64 + fr) * ldc + u.pn * BM + wc * 32 + 8 * fq;
#pragma unroll
        for (int ai = 0; ai < 2; ++ai)
#pragma unroll
            for (int m = 0; m < 4; ++m) { bf16_t* rowp = base + (size_t)(ai * HALF + m * 16) * ldc;
#pragma unroll
                for (int bj = 0; bj < 2; ++bj) *(u32x4*)(rowp + bj * HALF) = pack8(acc[ai][bj][m][0], acc[ai][bj][m][1]); }
    }
};

__device__ __forceinline__ float silu_mul(float g, float up) { return g * __builtin_amdgcn_rcpf(1.0f + __builtin_amdgcn_exp2f(-1.4426950408889634f * g)) * up; }
struct EpiSwiglu {
    static constexpr bool PERM = true, AFTER_DRAIN = false;
    bf16_t* O; int ldc;
    __device__ __forceinline__ void operator()(const f32x4 (&acc)[2][2][4][2], const Unit& u, int wr, int wc, int fr, int fq) const {
        asm volatile("" : "+v"(fr), "+v"(fq));
        bf16_t* base = O + (size_t)(u.pm * BM + wr * 64 + fr) * ldc + u.pn * HALF + wc * 32 + 8 * fq;
#pragma unroll
        for (int ai = 0; ai < 2; ++ai)
#pragma unroll
            for (int m = 0; m < 4; ++m) { f32x4 v[2];
#pragma unroll
                for (int n = 0; n < 2; ++n)
#pragma unroll
                    for (int j = 0; j < 4; j += 2) { const f32x2 g = {acc[ai][0][m][n][j], acc[ai][0][m][n][j + 1]}, up = {acc[ai][1][m][n][j], acc[ai][1][m][n][j + 1]};
                        const f32x2 t = g * -1.4426950408889634f; f32x2 d = {__builtin_amdgcn_exp2f(t.x), __builtin_amdgcn_exp2f(t.y)}; d = d + 1.0f;
                        const f32x2 r = {__builtin_amdgcn_rcpf(d.x), __builtin_amdgcn_rcpf(d.y)}; const f32x2 o = (g * up) * r; v[n][j] = o.x; v[n][j + 1] = o.y; }
                *(u32x4*)(base + (size_t)(ai * HALF + m * 16) * ldc) = pack8(v[0], v[1]); }
    }
};

struct EpiInProj {
    static constexpr bool PERM = true, AFTER_DRAIN = false;
    bf16_t* QB; bf16_t* KVB; bf16_t* Z; bf16_t* CB; const float* qkg; const float* ropec; const float* ropes;
    __device__ __forceinline__ void operator()(const f32x4 (&acc)[2][2][4][2], const Unit& u, int wr, int wc, int fr, int fq) const {
        asm volatile("" : "+v"(fr), "+v"(fq));
        const int pm = u.pm, pn = u.pn; const bool lat = pm < 256;
        const int rloc = wr * 64 + fr;
        if (pn >= 7) {
            if (pn == 9) { bf16_t* base = CB + (size_t)(pm * BM + rloc) * 256 + wc * 32 + 8 * fq;
#pragma unroll
                for (int ai = 0; ai < 2; ++ai)
#pragma unroll
                    for (int m = 0; m < 4; ++m)
#pragma unroll
                        for (int bj = 0; bj < 2; ++bj) *(u32x4*)(base + (size_t)(ai * HALF + m * 16) * 256 + bj * HALF) = pack8(acc[ai][bj][m][0], acc[ai][bj][m][1]);
            } else { bf16_t* base = Z + (size_t)(pm * BM + rloc) * 256 + (pn - 7) * HALF + wc * 32 + 8 * fq;
#pragma unroll
                for (int ai = 0; ai < 2; ++ai)
#pragma unroll
                    for (int m = 0; m < 4; ++m) *(u32x4*)(base + (size_t)(ai * HALF + m * 16) * 256) = pack8(acc[ai][0][m][0] * acc[ai][1][m][0], acc[ai][0][m][1] * acc[ai][1][m][1]);
            }
            return;
        }
        const int s = 4 * pn + wc; const bool isq = s < 12; const int nrm = (s < 6) ? 1 : ((s == 12 || s == 13) ? 2 : 0);
        const int kvrow0 = lat ? (pm >> 5) * 8448 + (pm & 31) * 256 : (pm - 256) * 8448 + 8192;
        bf16_t* dst = isq ? QB + (size_t)(pm * BM + rloc) * 768 + 64 * s + 8 * fq : KVB + (size_t)(kvrow0 + rloc) * 1024 + 64 * (s - 12) + 8 * fq;
        const int ld = isq ? 768 : 1024;
        const float qs = isq ? 0.125f * 1.4426950408889634f : 1.0f;
        if (nrm) {
            const float* gq = qkg + (nrm - 1) * 64 + 4 * fq;
#pragma unroll
            for (int ai = 0; ai < 2; ++ai) {
                const int grow = (pm & 31) * 4 + 2 * ai + wr;
#pragma unroll
                for (int m = 0; m < 4; ++m) {
                    float ss = 0.f;
#pragma unroll
                    for (int bj = 0; bj < 2; ++bj)
#pragma unroll
                        for (int n = 0; n < 2; ++n)
#pragma unroll
                            for (int j = 0; j < 4; ++j) ss += acc[ai][bj][m][n][j] * acc[ai][bj][m][n][j];
                    ss += __shfl_xor(ss, 16); ss += __shfl_xor(ss, 32);
                    const float rstd = qs / sqrtf(ss * (1.0f / 64.0f) + 1e-6f);
                    bf16_t* rowp = dst + (size_t)(ai * HALF + m * 16) * ld;
#pragma unroll
                    for (int bj = 0; bj < 2; ++bj) {
                        f32x4 v0 = acc[ai][bj][m][0] * rstd * *(const f32x4*)(gq + 32 * bj), v1 = acc[ai][bj][m][1] * rstd * *(const f32x4*)(gq + 32 * bj + 16);
                        if (lat) {
                            const int pos = bj ? (16 * m + fr) : grow;
                            const f32x4 cc = *(const f32x4*)(ropec + pos * 16 + 4 * fq), sc = *(const f32x4*)(ropes + pos * 16 + 4 * fq);
                            const f32x4 a1 = v0 * cc - v1 * sc, a2 = v1 * cc + v0 * sc; v0 = a1; v1 = a2;
                        }
                        *(u32x4*)(rowp + bj * 32) = pack8(v0, v1);
                    }
                    asm volatile("" ::: "memory");
                }
            }
        } else {
#pragma unroll
            for (int ai = 0; ai < 2; ++ai)
#pragma unroll
                for (int m = 0; m < 4; ++m) { bf16_t* rowp = dst + (size_t)(ai * HALF + m * 16) * ld;
#pragma unroll
                    for (int bj = 0; bj < 2; ++bj) *(u32x4*)(rowp + bj * 32) = pack8(acc[ai][bj][m][0] * qs, acc[ai][bj][m][1] * qs); }
        }
    }
};
template <class Epi, class Sched, bool ALIGN_EPI = false, bool SP2 = false>
__device__ __forceinline__ void gemm_phase(PG8_LAS unsigned char* lds, const Gemm g, const Sched& S, const Epi& E) {
    int tid_ = threadIdx.x; asm volatile("" : "+v"(tid_));
    const int tid = tid_, wid = __builtin_amdgcn_readfirstlane(tid >> 6), lane = tid & 63, wr = wid >> 2, wc = wid & 3; int fr = lane & 15, fq = lane >> 4;
    const int K = g.K, nt = K / BK;
    unsigned voffA[2], voffB[2];
#pragma unroll
    for (int i = 0; i < 2; ++i) { int R, C; stage_rc(tid * 16 + i * 8192, R, C); const int Rb = Epi::PERM ? ((R & ~31) + perm32(R & 31)) : R;
        voffA[i] = (unsigned)(R * K + C) * 2u; voffB[i] = (unsigned)(Rb * K + C) * 2u; }
    const size_t kstep = (size_t)(BK * 2);
    const size_t hstep = (size_t)HALF * K * 2;
    const size_t tstep = 2 * hstep;
    const unsigned ldsw = (unsigned)wid * 1024u;
    const int aoff = lds_byte(wr * 64 + fr, fq * 8), boff = lds_byte(wc * 32 + fr, fq * 8);
#define PG8_SA(b, h) (((b) * 2 + (h)) * HTB)
#define PG8_SB(b, h) ((4 + (b) * 2 + (h)) * HTB)
#define PG8_STAGE(bufoff, gbase, voff) do { _Pragma("unroll") for (int _i = 0; _i < 2; ++_i) \
        __builtin_amdgcn_global_load_lds((const unsigned*)((const char*)(gbase) + (voff)[_i]), (PG8_LAS unsigned*)(lds + (bufoff) + ldsw + _i * 8192), 16, 0, 0); } while (0)
#define PG8_LDA(dst, b, h) do { _Pragma("unroll") for (int m = 0; m < 4; ++m) _Pragma("unroll") for (int k = 0; k < 2; ++k) dst[m][k] = *(const PG8_LAS bf16x8*)(lds + PG8_SA(b, h) + aoff + m * 2048 + k * 1024); } while (0)
#define PG8_LDB(dst, b, h) do { _Pragma("unroll") for (int n = 0; n < 2; ++n) _Pragma("unroll") for (int k = 0; k < 2; ++k) dst[n][k] = *(const PG8_LAS bf16x8*)(lds + PG8_SB(b, h) + boff + n * 2048 + k * 1024); } while (0)
#define PG8_MMA(ai, bj, At, Bt) do { __builtin_amdgcn_s_setprio(1); _Pragma("unroll") for (int m = 0; m < 4; ++m) _Pragma("unroll") for (int n = 0; n < 2; ++n) _Pragma("unroll") for (int k = 0; k < 2; ++k) \
        acc[ai][bj][m][n] = __builtin_amdgcn_mfma_f32_16x16x32_bf16(Bt[n][k], At[m][k], acc[ai][bj][m][n], 0, 0, 0); __builtin_amdgcn_s_setprio(0); } while (0)
#define PG8_WAIT_V(n) asm volatile("s_waitcnt vmcnt(" #n ")" ::: "memory")
#define PG8_WAIT_L(n) asm volatile("s_waitcnt lgkmcnt(" #n ")" ::: "memory")
#define PG8_BAR __builtin_amdgcn_s_barrier()
#define PG8_SCHED __builtin_amdgcn_sched_barrier(0)
    Unit cur, nxt; int ui = 0;
    if (!S.next(0, cur)) return;
    f32x4 acc[2][2][4][2];
#pragma unroll
    for (int a = 0; a < 2; ++a)
#pragma unroll
        for (int b = 0; b < 2; ++b)
#pragma unroll
            for (int m = 0; m < 4; ++m)
#pragma unroll
                for (int n = 0; n < 2; ++n) acc[a][b][m][n] = (f32x4){0.f, 0.f, 0.f, 0.f};
    bf16x8 At[4][2], B0[2][2], B1[2][2];
    const char* cA = (const char*)g.A + (size_t)cur.pm * tstep; const char* cB = (const char*)g.Bt + (size_t)cur.pn * tstep;
    S.a_ready(cur);
    if constexpr (SP2) {
        PG8_STAGE(PG8_SB(0, 0), cB, voffB); PG8_STAGE(PG8_SB(0, 1), cB + hstep, voffB); PG8_STAGE(PG8_SA(0, 0), cA, voffA); PG8_STAGE(PG8_SA(0, 1), cA + hstep, voffA);
        if (wr == 1) PG8_BAR;
        PG8_WAIT_V(2); PG8_BAR;
        PG8_STAGE(PG8_SB(1, 0), cB + kstep, voffB); PG8_STAGE(PG8_SA(1, 0), cA + kstep, voffA); PG8_STAGE(PG8_SB(1, 1), cB + hstep + kstep, voffB);
        PG8_WAIT_V(6); PG8_BAR;
    } else {
        PG8_STAGE(PG8_SB(0, 0), cB, voffB); PG8_STAGE(PG8_SA(0, 0), cA, voffA); PG8_STAGE(PG8_SB(0, 1), cB + hstep, voffB); PG8_STAGE(PG8_SA(0, 1), cA + hstep, voffA);
        if (wr == 1) PG8_BAR;
        PG8_WAIT_V(4); PG8_BAR;
        PG8_STAGE(PG8_SB(1, 0), cB + kstep, voffB); PG8_STAGE(PG8_SA(1, 0), cA + kstep, voffA); PG8_STAGE(PG8_SB(1, 1), cB + hstep + kstep, voffB);
        PG8_WAIT_V(6); PG8_BAR;
    }
    for (;;) {
        const bool has_next = S.next(ui + 1, nxt);
        const char* nA = has_next ? (const char*)g.A + (size_t)nxt.pm * tstep : cA; const char* nB = has_next ? (const char*)g.Bt + (size_t)nxt.pn * tstep : cB;
        for (int t = 0; t < nt; t += 2) {
            const bool last = (t == nt - 2);
            const char* a1 = cA + (size_t)(t + 1) * kstep;
            const char* a2 = last ? nA : cA + (size_t)(t + 2) * kstep; const char* b2 = last ? nB : cB + (size_t)(t + 2) * kstep;
            const char* a3 = a2 + kstep; const char* b3 = b2 + kstep;
            if (last && has_next) S.a_ready(nxt);
            if constexpr (SP2) {
            PG8_LDB(B0, 0, 0); PG8_LDB(B1, 0, 1); PG8_SCHED; PG8_LDA(At, 0, 0); PG8_STAGE(PG8_SA(1, 1), a1 + hstep, voffA);
            PG8_WAIT_V(8); PG8_WAIT_L(0); PG8_BAR; PG8_MMA(0, 0, At, B0); PG8_MMA(0, 1, At, B1); PG8_BAR; PG8_SCHED;
            PG8_LDA(At, 0, 1); PG8_STAGE(PG8_SB(0, 0), b2, voffB); PG8_STAGE(PG8_SB(0, 1), b2 + hstep, voffB); PG8_STAGE(PG8_SA(0, 0), a2, voffA);
            PG8_WAIT_V(8); PG8_WAIT_L(0); PG8_BAR; PG8_MMA(1, 0, At, B0); PG8_MMA(1, 1, At, B1); PG8_BAR; PG8_SCHED;
            PG8_LDB(B0, 1, 0); PG8_LDB(B1, 1, 1); PG8_SCHED; PG8_LDA(At, 1, 0); PG8_STAGE(PG8_SA(0, 1), a2 + hstep, voffA);
            PG8_WAIT_V(8); PG8_WAIT_L(0); PG8_BAR; PG8_MMA(0, 0, At, B0); PG8_MMA(0, 1, At, B1); PG8_BAR; PG8_SCHED;
            PG8_LDA(At, 1, 1); PG8_STAGE(PG8_SB(1, 0), b3, voffB); PG8_STAGE(PG8_SB(1, 1), b3 + hstep, voffB); PG8_STAGE(PG8_SA(1, 0), a3, voffA);
            PG8_WAIT_V(8); PG8_WAIT_L(0); PG8_BAR; PG8_MMA(1, 0, At, B0); PG8_MMA(1, 1, At, B1); PG8_BAR; PG8_SCHED;
            } else {
            PG8_LDB(B0, 0, 0); PG8_SCHED; PG8_LDA(At, 0, 0); PG8_STAGE(PG8_SA(1, 1), a1 + hstep, voffA);
            PG8_WAIT_L(8); PG8_BAR; PG8_WAIT_L(0); PG8_MMA(0, 0, At, B0); PG8_BAR; PG8_SCHED;
            PG8_LDB(B1, 0, 1); PG8_STAGE(PG8_SB(0, 0), b2, voffB);
            PG8_BAR; PG8_WAIT_L(0); PG8_MMA(0, 1, At, B1); PG8_BAR;
            PG8_LDA(At, 0, 1); PG8_STAGE(PG8_SA(0, 0), a2, voffA);
            PG8_BAR; PG8_WAIT_L(0); PG8_MMA(1, 0, At, B0); PG8_BAR; PG8_SCHED;
            PG8_STAGE(PG8_SB(0, 1), b2 + hstep, voffB);
            PG8_WAIT_V(6); PG8_BAR; PG8_MMA(1, 1, At, B1); PG8_BAR;
            PG8_LDB(B0, 1, 0); PG8_SCHED; PG8_LDA(At, 1, 0); PG8_STAGE(PG8_SA(0, 1), a2 + hstep, voffA);
            PG8_WAIT_L(8); PG8_BAR; PG8_WAIT_L(0); PG8_MMA(0, 0, At, B0); PG8_BAR; PG8_SCHED;
            PG8_LDB(B1, 1, 1); PG8_STAGE(PG8_SB(1, 0), b3, voffB);
            PG8_BAR; PG8_WAIT_L(0); PG8_MMA(0, 1, At, B1); PG8_BAR;
            PG8_LDA(At, 1, 1); PG8_STAGE(PG8_SA(1, 0), a3, voffA);
            PG8_BAR; PG8_WAIT_L(0); PG8_MMA(1, 0, At, B0); PG8_BAR; PG8_SCHED;
            PG8_STAGE(PG8_SB(1, 1), b3 + hstep, voffB);
            PG8_WAIT_V(6); PG8_BAR; PG8_MMA(1, 1, At, B1); PG8_BAR;
            }
        }
        if constexpr (ALIGN_EPI) { if (wr == 0) PG8_BAR; }
        if constexpr (!Epi::AFTER_DRAIN) { E(acc, cur, wr, wc, fr, fq); S.done(cur); }
        if (!has_next) break;
#pragma unroll
        for (int a = 0; a < 2; ++a)
#pragma unroll
            for (int b = 0; b < 2; ++b)
#pragma unroll
                for (int m = 0; m < 4; ++m)
#pragma unroll
                    for (int n = 0; n < 2; ++n) acc[a][b][m][n] = (f32x4){0.f, 0.f, 0.f, 0.f};
        cur = nxt; cA = nA; cB = nB; ++ui;
        if constexpr (ALIGN_EPI) { if (wr == 1) PG8_BAR; }
    }
    PG8_WAIT_V(0);
    if constexpr (!ALIGN_EPI) { if (wr == 0) PG8_BAR; }
    PG8_BAR;
    if constexpr (Epi::AFTER_DRAIN) { E.fused(acc, cur, wr, wc, fr, fq, lds, wid, lane); S.done(cur); }
#undef PG8_SA
#undef PG8_SB
#undef PG8_STAGE
#undef PG8_LDA
#undef PG8_LDB
#undef PG8_MMA
#undef PG8_WAIT_V
#undef PG8_WAIT_L
#undef PG8_BAR
#undef PG8_SCHED
}
}
#include <hip/hip_bf16.h>
#include <cmath>
namespace attn_body {
using bf16=__hip_bfloat16;
using bf16x8=__attribute__((ext_vector_type(8)))short;
using s16x4=__attribute__((ext_vector_type(4)))short;
using f32x16=__attribute__((ext_vector_type(16)))float;
using u32x4=__attribute__((ext_vector_type(4)))unsigned;
constexpr int D=64;
constexpr int NW=8,QBLK=32,QB=QBLK*NW,KVBLK=64;
constexpr int ATTN_UNIT_ROWS=QB;
__device__ __forceinline__ int crow(int r,int hi){return (r&3)+8*(r>>2)+4*hi;}
#define SBAR() __builtin_amdgcn_sched_barrier(0)
typedef const __attribute__((address_space(3))) float* lds_cfptr;
__device__ __forceinline__ void bmask(f32x16&p0,f32x16&p1,bool rowok,lds_cfptr brow,int cq,int cs,int hi){
  const float NEG=-INFINITY;
  if(!rowok){
    #pragma unroll
    for(int r=0;r<16;++r){p0[r]=NEG;p1[r]=NEG;}
  } else {
    lds_cfptr bq=brow+(15-cq+4*hi);
    #pragma unroll
    for(int r=0;r<16;++r){const int kc=(r&3)+8*(r>>2); const int kk=kc+4*hi;
      p0[r]=((unsigned)(kk-cs)<16u)?p0[r]+bq[kc]:NEG; p1[r]=((unsigned)(kk+32-cs)<16u)?p1[r]+bq[kc+32]:NEG;}
  }
}
struct AttnJob { const bf16*Q0; const bf16*K0; const bf16*V0; bf16*O0; int qp,kvp,op; int NT,nt0,seg1; int r0,lo; lds_cfptr biasL; };
constexpr int NSLOT=3, SLOTB=8192;
constexpr int LDS_K=0, LDS_V=NSLOT*SLOTB, LDS_WS=2*NSLOT*SLOTB, LDS_OST=LDS_WS+NW*64*4, LDS_BYTES=LDS_OST+NW*4096;
constexpr float C2=0.125f*1.4426950408889634f;
__device__ __forceinline__ void glds16(const void*gsrc,unsigned lds_dst){unsigned keep;
  asm volatile("s_mov_b32 %0, m0\n\ts_mov_b32 m0, %2\n\ts_nop 0\n\tglobal_load_lds_dwordx4 %1, off\n\ts_mov_b32 m0, %0":"=&s"(keep):"v"(gsrc),"s"(lds_dst):"memory");}
__device__ __forceinline__ float max3f(float a,float b,float c){float r;asm("v_max3_f32 %0, %1, %2, %3":"=v"(r):"v"(a),"v"(b),"v"(c));return r;}
__device__ __forceinline__ float max2f(float a,float b){float r;asm("v_max_f32_e32 %0, %1, %2":"=v"(r):"v"(a),"v"(b));return r;}
__device__ __forceinline__ float fadd_s(float a,float b){float r;asm("v_add_f32_e32 %0, %1, %2":"=v"(r):"v"(a),"v"(b));return r;}
__device__ __forceinline__ float fsub_s(float a,float b){float r;asm("v_sub_f32_e32 %0, %1, %2":"=v"(r):"v"(a),"v"(b));return r;}
typedef float f32x2_t __attribute__((ext_vector_type(2))); typedef __bf16 bf16x2_t __attribute__((ext_vector_type(2)));
__device__ __forceinline__ unsigned cvtpk_s(float lo,float hi){f32x2_t v={lo,hi};bf16x2_t b=__builtin_convertvector(v,bf16x2_t);return __builtin_bit_cast(unsigned,b);}
#define WAIT_BAR(N) asm volatile("s_waitcnt vmcnt(" #N ") lgkmcnt(0)\n\ts_barrier":::"memory")

__device__ __forceinline__ void qkt(f32x16&p0,f32x16&p1,const char*Kslot,const bf16x8*qr,const f32x16&negm,int r32,int hi){
  const char*kb=Kslot+hi*1024+r32*16;
  #pragma unroll
  for(int d0=0;d0<4;++d0){
    const bf16x8 b0=*reinterpret_cast<const bf16x8*>(kb+d0*2048);
    const bf16x8 b1=*reinterpret_cast<const bf16x8*>(kb+d0*2048+512);
    if(d0==0){p0=__builtin_amdgcn_mfma_f32_32x32x16_bf16(b0,qr[0],negm,0,0,0);p1=__builtin_amdgcn_mfma_f32_32x32x16_bf16(b1,qr[0],negm,0,0,0);}
    else{p0=__builtin_amdgcn_mfma_f32_32x32x16_bf16(b0,qr[d0],p0,0,0,0);p1=__builtin_amdgcn_mfma_f32_32x32x16_bf16(b1,qr[d0],p1,0,0,0);}}
}
typedef __attribute__((address_space(3))) const char* lds_cptr;
typedef short v4i16_t __attribute__((ext_vector_type(4)));
__device__ __forceinline__ void kload8(bf16x8*kf,lds_cptr kp){
  kf[0]=*(const __attribute__((address_space(3))) bf16x8*)(kp);      kf[1]=*(const __attribute__((address_space(3))) bf16x8*)(kp+512);
  kf[2]=*(const __attribute__((address_space(3))) bf16x8*)(kp+2048); kf[3]=*(const __attribute__((address_space(3))) bf16x8*)(kp+2560);
  kf[4]=*(const __attribute__((address_space(3))) bf16x8*)(kp+4096); kf[5]=*(const __attribute__((address_space(3))) bf16x8*)(kp+4608);
  kf[6]=*(const __attribute__((address_space(3))) bf16x8*)(kp+6144); kf[7]=*(const __attribute__((address_space(3))) bf16x8*)(kp+6656);
}
__device__ __forceinline__ void kload2(bf16x8*kf,lds_cptr kp,int j){ kf[2*j]=*(const __attribute__((address_space(3))) bf16x8*)(kp+j*2048); kf[2*j+1]=*(const __attribute__((address_space(3))) bf16x8*)(kp+j*2048+512); }
__device__ __forceinline__ s16x4 vtr(lds_cptr p){ return __builtin_bit_cast(s16x4,__builtin_amdgcn_ds_read_tr16_b64_v4i16((__attribute__((address_space(3))) v4i16_t*)p)); }
__device__ __forceinline__ float rowmax(const f32x16&p0,const f32x16&p1){
  float a=max3f(p0[0],p0[1],p1[0]),b=max3f(p0[2],p0[3],p1[1]);a=max3f(a,p1[2],p1[3]);
  #pragma unroll
  for(int r=4;r<16;r+=4){a=max3f(a,p0[r],p0[r+1]);b=max3f(b,p0[r+2],p0[r+3]);a=max3f(a,p1[r],p1[r+1]);b=max3f(b,p1[r+2],p1[r+3]);}
  const float m=max2f(a,b);
  auto rr=__builtin_amdgcn_permlane32_swap(__float_as_uint(m),__float_as_uint(m),false,false);
  return max2f(__uint_as_float(rr[0]),__uint_as_float(rr[1]));
}
__device__ __forceinline__ void pv(f32x16*o,int vb,bf16x8 pa0,bf16x8 pa1,bf16x8 pa2,bf16x8 pa3){
  #pragma unroll
  for(int d0=0;d0<2;++d0){s16x4 lo[4],hi[4];
    #pragma unroll
    for(int ks=0;ks<4;++ks){
      asm volatile("ds_read_b64_tr_b16 %0,%1 offset:%c2":"=&v"(lo[ks]):"v"(vb),"i"(d0*4096+ks*1024):"memory");
      asm volatile("ds_read_b64_tr_b16 %0,%1 offset:%c2":"=&v"(hi[ks]):"v"(vb),"i"(d0*4096+ks*1024+512):"memory");}
    asm volatile("s_waitcnt lgkmcnt(0)":::"memory");SBAR();
    #define PK(k) (bf16x8){lo[k][0],lo[k][1],lo[k][2],lo[k][3],hi[k][0],hi[k][1],hi[k][2],hi[k][3]}
    o[d0]=__builtin_amdgcn_mfma_f32_32x32x16_bf16(pa0,PK(0),o[d0],0,0,0);
    o[d0]=__builtin_amdgcn_mfma_f32_32x32x16_bf16(pa1,PK(1),o[d0],0,0,0);
    o[d0]=__builtin_amdgcn_mfma_f32_32x32x16_bf16(pa2,PK(2),o[d0],0,0,0);
    o[d0]=__builtin_amdgcn_mfma_f32_32x32x16_bf16(pa3,PK(3),o[d0],0,0,0);
    #undef PK
  }
}

#ifndef ATTN_STORE16
#define ATTN_STORE16(p,v) (*(u32x4*)(p)=(v))
#endif
template<int THRL,int MODE> __device__ __forceinline__ void attn_unit(const AttnJob&J,char*shm){
  int tid_=threadIdx.x; asm volatile("":"+v"(tid_)); const int tid=tid_,lane=tid&63,r32=lane&31,hi=lane>>5; const int wid=__builtin_amdgcn_readfirstlane(tid>>6);
  const int QP=J.qp,KVP=J.kvp,OP=J.op,nt0=J.nt0,seg1=J.seg1;
  const bf16*Qw=J.Q0+(long)(wid*QBLK)*QP;
  const bf16*Kh=J.K0,*Vh=J.V0;
  const unsigned lds0=(unsigned)(uintptr_t)shm;
  float*wsf=(float*)(shm+LDS_WS)+wid*64;
  const bf16*ksrc=Kh+(long)lane*KVP+wid*8;
  const bf16*vsrc=Vh+(long)(16*(wid&3)+(lane>>2))*KVP+(wid>>2)*32+(lane&3)*8;
  const unsigned kdst=lds0+LDS_K+wid*1024, vdst=lds0+LDS_V+wid*1024;
  #define TROW(t) (((t)<nt0)?(t)*KVBLK:seg1+((t)-nt0)*KVBLK)
  #define DMA_K(t,slot) glds16(ksrc+(long)TROW(t)*KVP,(unsigned)__builtin_amdgcn_readfirstlane(kdst+(slot)))
  #define DMA_V(t,slot) glds16(vsrc+(long)TROW(t)*KVP,(unsigned)__builtin_amdgcn_readfirstlane(vdst+(slot)))
  const int vb0=(int)(lds0+LDS_V)+((lane>>4)&1)*32+(lane&3)*8+(4*hi+((lane&15)>>2))*64;
  const char*Kbase=shm+LDS_K; bf16x8 kf[8];
  const lds_cptr shm3=(lds_cptr)shm; const lds_cptr kp0=shm3+LDS_K+hi*1024+r32*16; const lds_cptr vp0=shm3+LDS_V+((lane>>4)&1)*32+(lane&3)*8+(4*hi+((lane&15)>>2))*64;
  const int NT=J.NT;
  DMA_K(0,0);DMA_V(0,0);DMA_K(1,SLOTB);
  bf16x8 qr[4];
  #pragma unroll
  for(int d0=0;d0<4;++d0)qr[d0]=*reinterpret_cast<const bf16x8*>(&Qw[(long)r32*QP+d0*16+hi*8]);
  float mhat=0.f,l_reg=0.f;f32x16 o[2];o[0]=f32x16{};o[1]=f32x16{};f32x16 negm=f32x16{};asm volatile("":"+v"(negm));
  const int rq_=J.r0+(wid>>1),cq_=32*(wid&1)+r32; const int rs_=min(max(rq_-4,0),120),cs_=min(max(cq_-8,0),48);
  #define CMASK(P0,P1,t) do{ if constexpr(MODE==1){ if((t)>=nt0){ const int kr_=J.lo+((t)-nt0); bmask(P0,P1,(kr_>=rs_&&kr_<rs_+8),J.biasL+(kr_-rq_+7)*31,cq_,cs_,hi); } } }while(0)
  bool resc=false;
  #define START(P0,P1) do{ resc=false; \
    if constexpr(MODE!=2){ const float rm=rowmax(P0,P1); const float dl=rm; mhat=fadd_s(mhat,dl); \
      _Pragma("unroll") for(int r=0;r<16;++r){P0[r]=fsub_s(P0[r],dl);P1[r]=fsub_s(P1[r],dl);} \
      _Pragma("unroll") for(int r=0;r<16;++r)negm[r]=-mhat; asm volatile("":"+v"(negm)); } \
    _Pragma("unroll") for(int r=0;r<16;++r)P0[r]=__builtin_amdgcn_exp2f(P0[r]); }while(0)
  #define RESC() do{ if(resc){ asm volatile("s_waitcnt lgkmcnt(0)":::"memory"); \
      _Pragma("unroll") for(int d_=0;d_<2;++d_) _Pragma("unroll") for(int r=0;r<16;++r)o[d_][r]*=wsf[crow(r,hi)]; } }while(0)
  f32x16 pA0,pA1,pB0,pB1;
  int sl_prev=0,sl_cur=0,sl_next=SLOTB;
  #define ROT() do{sl_prev=sl_cur;sl_cur=sl_next;sl_next=(sl_next==(NSLOT-1)*SLOTB)?0:sl_next+SLOTB;}while(0)
  DMA_K(2,2*SLOTB);
  WAIT_BAR(3);
  qkt(pA0,pA1,Kbase,qr,negm,r32,hi);asm volatile("s_nop 15\n\ts_nop 7":"+v"(pA0),"+v"(pA1));CMASK(pA0,pA1,0);
  START(pA0,pA1);
  _Pragma("unroll") for(int r=0;r<16;++r)pA1[r]=__builtin_amdgcn_exp2f(pA1[r]);
  WAIT_BAR(0);
  DMA_K(3,0);DMA_V(1,SLOTB);
  ROT();
  kload8(kf,kp0+sl_cur);
  WAIT_BAR(2);
  s16x4 vlo[8],vhi[8]; u32x4 pw0,pw1,pw2,pw3;
  #define PKW(P,B) cvtpk_s(P[B],P[B+1])
  #define PAF(k) __builtin_bit_cast(bf16x8,pw##k)
  #define VFR(i) (bf16x8){vlo[i][0],vlo[i][1],vlo[i][2],vlo[i][3],vhi[i][0],vhi[i][1],vhi[i][2],vhi[i][3]}
  #define PIN(x) asm volatile("":"+v"(x))
  #define MX3(a,b,c) __builtin_fmaxf(__builtin_fmaxf((a),(b)),(c))
  #define GAPA(MF,A0,A1,A2,A3,W0,W1,PW) do{ MF; sacc+=A0; sacc+=A1; sacc+=A2; sacc+=A3; PIN(sacc); W0; W1; PIN(PW); SBAR(); }while(0)
  #define EX(v) __builtin_amdgcn_exp2f(v)
  #define GAPB(MF,X,B) do{ MF; X[B]=EX(X[B]); X[B+1]=EX(X[B+1]); X[B+2]=EX(X[B+2]); X[B+3]=EX(X[B+3]); PIN(X); SBAR(); }while(0)
  #define VRD(i) do{ vlo[i]=vtr(vp_+(((i)>>2)*4096+((i)&3)*1024)); vhi[i]=vtr(vp_+(((i)>>2)*4096+((i)&3)*1024+512)); }while(0)
  #define KRD(G,j) do{ if(G){ kload2(kf,kp0+sl_next,j); SBAR(); } }while(0)
  #define STEP(C0,C1,P0,P1,t,GK,GV,GL) do{ SBAR(); \
    const lds_cptr vp_=vp0+sl_prev; \
    VRD(0); SBAR(); float sacc=(P0[0]+P0[1]); \
    GAPA(C0=__builtin_amdgcn_mfma_f32_32x32x16_bf16(kf[0],qr[0],negm,0,0,0), P0[2],P0[3],P0[4],P0[5],     pw0[0]=PKW(P0,0), pw0[1]=PKW(P0,2), pw0); \
    VRD(4); SBAR(); GAPA(C1=__builtin_amdgcn_mfma_f32_32x32x16_bf16(kf[1],qr[0],negm,0,0,0), P0[6],P0[7],P0[8],P0[9],     pw0[2]=PKW(P0,4), pw0[3]=PKW(P0,6), pw0); \
    VRD(1); SBAR(); GAPA(C0=__builtin_amdgcn_mfma_f32_32x32x16_bf16(kf[2],qr[1],C0,0,0,0),   P0[10],P0[11],P0[12],P0[13], pw1[0]=PKW(P0,8), pw1[1]=PKW(P0,10), pw1); \
    VRD(5); SBAR(); GAPA(C1=__builtin_amdgcn_mfma_f32_32x32x16_bf16(kf[3],qr[1],C1,0,0,0),   P0[14],P0[15],P1[0],P1[1],   pw1[2]=PKW(P0,12),pw1[3]=PKW(P0,14), pw1); \
    VRD(2); SBAR(); GAPA(C0=__builtin_amdgcn_mfma_f32_32x32x16_bf16(kf[4],qr[2],C0,0,0,0),   P1[2],P1[3],P1[4],P1[5],     pw2[0]=PKW(P1,0), pw2[1]=PKW(P1,2), pw2); \
    VRD(6); SBAR(); GAPA(C1=__builtin_amdgcn_mfma_f32_32x32x16_bf16(kf[5],qr[2],C1,0,0,0),   P1[6],P1[7],P1[8],P1[9],     pw2[2]=PKW(P1,4), pw2[3]=PKW(P1,6), pw2); \
    VRD(3); SBAR(); GAPA(C0=__builtin_amdgcn_mfma_f32_32x32x16_bf16(kf[6],qr[3],C0,0,0,0),   P1[10],P1[11],P1[12],P1[13], pw3[0]=PKW(P1,8), pw3[1]=PKW(P1,10), pw3); \
    VRD(7); SBAR(); GAPA(C1=__builtin_amdgcn_mfma_f32_32x32x16_bf16(kf[7],qr[3],C1,0,0,0),   P1[14],P1[15],0.f,0.f,       pw3[2]=PKW(P1,12),pw3[3]=PKW(P1,14), pw3); \
    l_reg+=sacc; \
    if(GK){DMA_K((t)+3,sl_cur);} if(GV){DMA_V((t)+1,sl_next);} \
    CMASK(C0,C1,t); \
    if constexpr(MODE!=2){ float a=MX3(C0[0],C0[1],C1[0]),b=MX3(C0[2],C0[3],C1[1]); a=MX3(a,C1[2],C1[3]); \
      _Pragma("unroll") for(int r=4;r<16;r+=4){a=MX3(a,C0[r],C0[r+1]);b=MX3(b,C0[r+2],C0[r+3]);a=MX3(a,C1[r],C1[r+1]);b=MX3(b,C1[r+2],C1[r+3]);} \
      float rm=__builtin_fmaxf(a,b); { auto rr=__builtin_amdgcn_permlane32_swap(__float_as_uint(rm),__float_as_uint(rm),false,false); rm=__builtin_fmaxf(__uint_as_float(rr[0]),__uint_as_float(rr[1])); } \
      resc=false; \
      if(__builtin_expect(__any(rm>(float)THRL),0)){ const float dl=__builtin_fmaxf(rm,0.f); mhat+=dl; \
        _Pragma("unroll") for(int r=0;r<16;++r){C0[r]-=dl;C1[r]-=dl;} \
        _Pragma("unroll") for(int r=0;r<16;++r)negm[r]=-mhat; asm volatile("":"+v"(negm)); \
        const float f=__builtin_amdgcn_exp2f(-dl); l_reg*=f; if(hi==0)wsf[r32]=f; resc=true; } } \
    SBAR(); \
    GAPB(o[0]=__builtin_amdgcn_mfma_f32_32x32x16_bf16(PAF(0),VFR(0),o[0],0,0,0), C0,0); \
    GAPB(o[1]=__builtin_amdgcn_mfma_f32_32x32x16_bf16(PAF(0),VFR(4),o[1],0,0,0), C0,4); \
    KRD(GL,0); GAPB(o[0]=__builtin_amdgcn_mfma_f32_32x32x16_bf16(PAF(1),VFR(1),o[0],0,0,0), C0,8); \
    KRD(GL,1); GAPB(o[1]=__builtin_amdgcn_mfma_f32_32x32x16_bf16(PAF(1),VFR(5),o[1],0,0,0), C0,12); \
    KRD(GL,2); GAPB(o[0]=__builtin_amdgcn_mfma_f32_32x32x16_bf16(PAF(2),VFR(2),o[0],0,0,0), C1,0); \
    KRD(GL,3); GAPB(o[1]=__builtin_amdgcn_mfma_f32_32x32x16_bf16(PAF(2),VFR(6),o[1],0,0,0), C1,4); \
    GAPB(o[0]=__builtin_amdgcn_mfma_f32_32x32x16_bf16(PAF(3),VFR(3),o[0],0,0,0), C1,8); \
    GAPB(o[1]=__builtin_amdgcn_mfma_f32_32x32x16_bf16(PAF(3),VFR(7),o[1],0,0,0), C1,12); \
    }while(0)
  int t=1;
  #undef CMASK
  #define CMASK(P0,P1,t) do{ if constexpr(MODE==1){ if((t)>=nt0){ const int kr_=J.lo+((t)-nt0); bmask(P0,P1,(kr_>=rs_&&kr_<rs_+8),J.biasL+(kr_-rq_+7)*31,cq_,cs_,hi); } } }while(0)
  for(;t+5<NT;t+=2){
    STEP(pB0,pB1,pA0,pA1,t,true,true,true);     WAIT_BAR(2); RESC(); ROT();
    STEP(pA0,pA1,pB0,pB1,t+1,true,true,true);   WAIT_BAR(2); RESC(); ROT();
  }
  #undef CMASK
  #define CMASK(P0,P1,t) do{ if constexpr(MODE==1){ if((t)>=nt0){ const int kr_=J.lo+((t)-nt0); bmask(P0,P1,(kr_>=rs_&&kr_<rs_+8),J.biasL+(kr_-rq_+7)*31,cq_,cs_,hi); } } }while(0)
  #define ENDW(tt) do{ if((tt)+3<NT){WAIT_BAR(2);} else if((tt)+2<NT){WAIT_BAR(1);} else {WAIT_BAR(0);} }while(0)
  for(;t+1<NT;t+=2){
    STEP(pB0,pB1,pA0,pA1,t,(t+3<NT),(t+1<NT),(t+1<NT));       ENDW(t);   RESC(); ROT();
    STEP(pA0,pA1,pB0,pB1,t+1,(t+4<NT),(t+2<NT),(t+2<NT));     ENDW(t+1); RESC(); ROT();
  }
  STEP(pB0,pB1,pA0,pA1,NT-1,false,false,false); RESC();
  { float sacc=pB0[0]+pB0[1]; _Pragma("unroll") for(int r=2;r<16;++r)sacc+=pB0[r]; _Pragma("unroll") for(int r=0;r<16;++r)sacc+=pB1[r]; l_reg+=sacc;
    pw0=(u32x4){PKW(pB0,0),PKW(pB0,2),PKW(pB0,4),PKW(pB0,6)};pw1=(u32x4){PKW(pB0,8),PKW(pB0,10),PKW(pB0,12),PKW(pB0,14)};pw2=(u32x4){PKW(pB1,0),PKW(pB1,2),PKW(pB1,4),PKW(pB1,6)};pw3=(u32x4){PKW(pB1,8),PKW(pB1,10),PKW(pB1,12),PKW(pB1,14)};
    SBAR(); pv(o,vb0+sl_cur,PAF(0),PAF(1),PAF(2),PAF(3)); }
  #undef PKW
  #undef PAF
  #undef VFR
  #undef PIN
  #undef MX3
  #undef GAPA
  #undef GAPB
  #undef EX
  #undef VRD
  #undef KRD
  #undef STEP
  #undef ENDW
  {auto rr=__builtin_amdgcn_permlane32_swap(__float_as_uint(l_reg),__float_as_uint(l_reg),false,false);l_reg=__uint_as_float(rr[0])+__uint_as_float(rr[1]);}
  if(hi==0)wsf[32+r32]=l_reg;asm volatile("s_waitcnt lgkmcnt(0)":::"memory");
  float rli[16];
  #pragma unroll
  for(int r=0;r<16;++r)rli[r]=__builtin_amdgcn_rcpf(wsf[32+crow(r,hi)]);
  bf16*Ow=J.O0+(long)(wid*QBLK)*OP;
  { bf16*stg=(bf16*)(shm+LDS_OST)+wid*2048;
    #pragma unroll
    for(int r=0;r<16;++r){const int orow=crow(r,hi);
      #pragma unroll
      for(int d0=0;d0<2;++d0)stg[orow*64+d0*32+r32]=__float2bfloat16(o[d0][r]*rli[r]);}
    asm volatile("s_waitcnt lgkmcnt(0)":::"memory");
    #pragma unroll
    for(int i=0;i<4;++i){const int row=i*8+(lane>>3),ch=lane&7; const u32x4 v=*(const u32x4*)(stg+row*64+ch*8); ATTN_STORE16(Ow+(long)row*OP+ch*8,v);} }
  asm volatile("s_waitcnt lgkmcnt(0)\n\ts_barrier":::"memory");
  #undef DMA_K
  #undef DMA_V
  #undef TROW
  #undef CMASK
  #undef START
  #undef RESC
  #undef ROT
}
constexpr int ATTN_LDS_BYTES=LDS_BYTES;
#undef SBAR
#undef WAIT_BAR
}
#define GAS __attribute__((address_space(1)))
#define LAS __attribute__((address_space(3)))
#define XB_TMO      128
#define XB_XCNT(j)  (256  + 64 * (j))
#define XB_XSUB(j)  (1280 + 64 * (j))
#define XB_XGEN(j)  (2304 + 64 * (j))
#define XB_TOP      3328
#define XB_TOPGEN   3392
#define XCD_BAR_WORDS 3456
#define XB_SPIN_CAP (1u << 18)

__device__ __forceinline__ unsigned xb_ld(unsigned* p)              { return __hip_atomic_load(p, __ATOMIC_RELAXED, __HIP_MEMORY_SCOPE_AGENT); }
__device__ __forceinline__ unsigned xb_add(unsigned* p, unsigned v) { return __hip_atomic_fetch_add(p, v, __ATOMIC_RELAXED, __HIP_MEMORY_SCOPE_AGENT); }
__device__ __forceinline__ unsigned xb_xcc_id() { return (unsigned)__builtin_amdgcn_s_getreg((3 << 11) | 20) & 0xFu; }
#define XB_SPIN(cond, bar) do { unsigned _sp = 0; while (cond) { __builtin_amdgcn_s_sleep(1); \
    if ((++_sp & 255u) == 0u) { if (xb_ld(&(bar)[XB_TMO])) break; if (_sp > XB_SPIN_CAP) { atomicAdd(&(bar)[XB_TMO], 1u); break; } } } } while (0)

struct XcdBarrier {
    unsigned* bar; unsigned x;
    volatile LAS unsigned* st;
};

__device__ __forceinline__ XcdBarrier xcd_barrier_post(unsigned* bar, volatile LAS unsigned* st) {
    XcdBarrier b; b.bar = bar; b.x = xb_xcc_id(); b.st = st;
    if (threadIdx.x == 0) (void)xb_add(&bar[XB_XCNT(b.x)], 1u);
    return b;
}
__device__ __forceinline__ void xcd_barrier_complete(unsigned* bar, unsigned x, unsigned& nloc, unsigned& nx) {
    const unsigned G = gridDim.x * gridDim.y * gridDim.z;
    unsigned sum, cnt, mine, sp = 0u;
    for (;;) {
        sum = 0u; cnt = 0u; mine = 0u;
#pragma unroll
        for (unsigned j = 0; j < 16; ++j) { const unsigned c = xb_ld(&bar[XB_XCNT(j)]); sum += c; cnt += (c > 0u) ? 1u : 0u; mine = (j == x) ? c : mine; }
        if (sum == G) break;
        __builtin_amdgcn_s_sleep(1);
        if ((++sp & 255u) == 0u) { if (xb_ld(&bar[XB_TMO])) break; if (sp > XB_SPIN_CAP) { atomicAdd(&bar[XB_TMO], 1u); break; } }
    }
    nloc = mine > 0u ? mine : 1u; nx = cnt > 0u ? cnt : 1u;
}

__device__ __forceinline__ void xcd_barrier(const XcdBarrier& b) {
    asm volatile("s_waitcnt vmcnt(0)" ::: "memory");
    __syncthreads();
    if (threadIdx.x == 0) {
        unsigned* bar = b.bar;
        __builtin_amdgcn_s_waitcnt(0);
        unsigned nloc = b.st[0], nx = b.st[1];
        if (nloc == 0u) { xcd_barrier_complete(bar, b.x, nloc, nx); b.st[0] = nloc; b.st[1] = nx; }
        const unsigned old = xb_add(&bar[XB_XSUB(b.x)], 1u);
        const unsigned gen = old / nloc;
        if (old + 1u == (gen + 1u) * nloc) {
            __builtin_amdgcn_fence(__ATOMIC_RELEASE, "agent");
            asm volatile("s_waitcnt vmcnt(0)" ::: "memory");
            const unsigned og = xb_add(&bar[XB_TOP], 1u);
            const unsigned tg = og / nx;
            if (og + 1u == (tg + 1u) * nx) xb_add(&bar[XB_TOPGEN], 1u);
            else XB_SPIN(xb_ld(&bar[XB_TOPGEN]) == tg, bar);
            __builtin_amdgcn_fence(__ATOMIC_ACQUIRE, "agent");
            xb_add(&bar[XB_XGEN(b.x)], 1u);
            asm volatile("s_waitcnt vmcnt(0)" ::: "memory");
        } else {
            XB_SPIN(xb_ld(&bar[XB_XGEN(b.x)]) == gen, bar);
            __builtin_amdgcn_fence(__ATOMIC_ACQUIRE, "agent");
            asm volatile("s_waitcnt vmcnt(0)" ::: "memory");
        }
    }
    __syncthreads();
}
namespace cg = cooperative_groups;
constexpr int NWAVES = 8;
constexpr int DM = 1024, NB = 8, SEQ = 8192, CTX = 256, ML = NB * SEQ, MC = NB * CTX, MT = ML + MC, KVS = SEQ + CTX;
constexpr int FF = 2816, NPROJ = 2560, NMOD = 9, DEPTH = 2;
constexpr float EPS = 1e-6f, LOG2E = 1.4426950408889634f;
constexpr size_t MiB = 1u << 20;
constexpr size_t WS_MOD = 0, WS_ROPE = 1 * MiB, WS_HC = 2 * MiB, WS_CTL = 12 * MiB, CTL_BYTES = 524288, WS_XB = 800 * MiB, WS_END2 = 816 * MiB, WS_W = 16 * MiB, W_LAYER = 40 * MiB;
constexpr size_t WO_WI = 0, WO_WD = 22 * MiB, WO_WIN = 33 * MiB, WO_WO = 38 * MiB;
constexpr size_t WS_U = 96 * MiB, WS_Y = 228 * MiB, WS_OV = 360 * MiB;
constexpr size_t WS_HID = WS_OV, WS_QB = WS_OV, WS_KVB = WS_OV + 99 * MiB, WS_Z = WS_OV + 231 * MiB, WS_CB = WS_OV + 264 * MiB, WS_O = WS_OV + 297 * MiB, WS_END = WS_OV + 429 * MiB;
static_assert((size_t)MT * 768 * 2 == 99 * MiB && (size_t)MT * 1024 * 2 == 132 * MiB && (size_t)MT * 256 * 2 == 33 * MiB && (size_t)MT * FF * 2 == 363 * MiB, "map");
constexpr int RING_BYTES = 131072, LDS_BYTES = 147456, BIAS_OFF = 90112, MISC_OFF = RING_BYTES + 320, XS_OFF = RING_BYTES + 1024;

typedef unsigned short bf16;
typedef unsigned v4u __attribute__((ext_vector_type(4)));
typedef unsigned v2u __attribute__((ext_vector_type(2)));
typedef float f32x4 __attribute__((ext_vector_type(4)));
#define LDS_WAIT() asm volatile("s_waitcnt lgkmcnt(0)" ::: "memory")
__device__ __forceinline__ unsigned f2bf(float f) { unsigned u = __builtin_bit_cast(unsigned, f); return (u + 0x7fffu + ((u >> 16) & 1u)) >> 16; }
__device__ __forceinline__ unsigned pk2(float lo, float hi) { return f2bf(lo) | (f2bf(hi) << 16); }
__device__ __forceinline__ float bf2f(unsigned h) { return __builtin_bit_cast(float, h << 16); }
typedef _Float16 h16x2 __attribute__((ext_vector_type(2)));
typedef float f32x2h __attribute__((ext_vector_type(2)));
__device__ __forceinline__ unsigned pkh2(float lo, float hi) { const f32x2h v = {lo, hi}; return __builtin_bit_cast(unsigned, __builtin_convertvector(v, h16x2)); }
__device__ __forceinline__ f32x2h uph2(unsigned u) { return __builtin_convertvector(__builtin_bit_cast(h16x2, u), f32x2h); }
__device__ __forceinline__ float wave_sum(float v) {
#pragma unroll
    for (int o = 1; o < 64; o <<= 1) v += __shfl_xor(v, o);
    return v;
}
__device__ __forceinline__ int src_col(int mode, int n) {
    if (mode == 0) return n;
    if (mode == 1) { const int pn = n >> 8, bj = (n >> 7) & 1, c = n & 127; return bj * FF + 128 * pn + c; }
    const int pn = n >> 8, p = n & 255;
    if (pn == 9) return 2048 + p;
    if (pn >= 7) return ((p >> 7) ? 2304 : 1792) + 128 * (pn - 7) + (p & 127);
    const int bj = p >> 7, wc = (p >> 5) & 3, i5 = p & 31, s = 4 * pn + wc;
    const bool qk = (s < 14) || (s >= 16 && s < 22);
    const int din = qk ? (16 * ((i5 >> 2) & 1) + 4 * (i5 >> 3) + (i5 & 3)) : i5;
    return 64 * s + 32 * bj + din;
}
__device__ __forceinline__ void transpose_item(const float* W, int K, int N, bf16* WT, int mode, LAS float* scr, int item, int lane) {
    const int nblk = N / 32, kb = item / nblk, nb = item % nblk, k0 = 64 * kb, n0 = 32 * nb;
    const int sc = src_col(mode, n0 + (lane & 31));
#pragma unroll 8
    for (int i = 0; i < 32; ++i) { const int kk = 2 * i + (lane >> 5); scr[kk * 33 + (lane & 31)] = W[(size_t)(k0 + kk) * N + sc]; }
    LDS_WAIT(); asm volatile("" ::: "memory");
    const int c = lane & 7;
#pragma unroll
    for (int j = 0; j < 4; ++j) { const int n = (lane >> 3) + 8 * j; const LAS float* s = scr + (8 * c) * 33 + n;
        v4u o; o.x = pk2(s[0 * 33], s[1 * 33]); o.y = pk2(s[2 * 33], s[3 * 33]); o.z = pk2(s[4 * 33], s[5 * 33]); o.w = pk2(s[6 * 33], s[7 * 33]);
        *(GAS v4u*)(WT + (size_t)(n0 + n) * K + k0 + 8 * c) = o; }
    LDS_WAIT(); asm volatile("" ::: "memory");
}

struct Args { const float* in[14]; float* out; unsigned char* ws; };

struct EwParams { const float* hin_lat; const float* hin_ctx; float* hout_lat; float* hout_ctx; const bf16* Y; bf16* U; int nrows; int post, pre; float wres;
                  const float* mod_post; int gate_i; const float* gpost; const float* mod_pre; int shift_i; const float* gpre; bf16* Hb; int fin, hb_store; };
template <int NR> __device__ __forceinline__ void ew_rows(const EwParams& P, const int row0, const int rstride, const int lane) {
    const float* hi_[NR]; float* ho_[NR]; int mrow[NR]; f32x4 h[NR][4];
#pragma unroll
    for (int q = 0; q < NR; ++q) { const int row = row0 + q * rstride; const bool lat = row < ML; mrow[q] = lat ? (row >> 13) : 8;
        hi_[q] = lat ? P.hin_lat + (size_t)row * DM : P.hin_ctx + (size_t)(row - ML) * DM; ho_[q] = lat ? P.hout_lat + (size_t)row * DM : P.hout_ctx + (size_t)(row - ML) * DM;
#pragma unroll
        for (int j = 0; j < 4; ++j) h[q][j] = __builtin_nontemporal_load((const GAS f32x4*)hi_[q] + lane + 64 * j); }
    if (P.post) {
        f32x4 y[NR][4]; float s[NR];
#pragma unroll
        for (int q = 0; q < NR; ++q) { s[q] = 0.f;
#pragma unroll
            for (int j = 0; j < 4; ++j) { const v2u w = __builtin_nontemporal_load((const GAS v2u*)(P.Y + (size_t)(row0 + q * rstride) * DM) + lane + 64 * j);
                y[q][j] = (f32x4){bf2f(w.x & 0xffffu), bf2f(w.x >> 16), bf2f(w.y & 0xffffu), bf2f(w.y >> 16)};
                s[q] += (y[q][j].x * y[q][j].x + y[q][j].y * y[q][j].y) + (y[q][j].z * y[q][j].z + y[q][j].w * y[q][j].w); } }
#pragma unroll
        for (int q = 0; q < NR; ++q) {
            const float rstd = P.wres / sqrtf(wave_sum(s[q]) * (1.f / DM) + EPS);
            const float* gate = P.mod_post + (size_t)mrow[q] * (NMOD * DM) + P.gate_i * DM;
#pragma unroll
            for (int j = 0; j < 4; ++j) { const f32x4 g = ((const GAS f32x4*)gate)[lane + 64 * j], gp = ((const GAS f32x4*)P.gpost)[lane + 64 * j];
                h[q][j] = h[q][j] + g * (y[q][j] * rstd) * gp; }
        }
    }
#pragma unroll
    for (int q = 0; q < NR; ++q)
        if (P.post || hi_[q] != ho_[q]) {
#pragma unroll
            for (int j = 0; j < 4; ++j) ((GAS f32x4*)ho_[q])[lane + 64 * j] = h[q][j];
        }
    if (P.hb_store) {
#pragma unroll
        for (int q = 0; q < NR; ++q)
#pragma unroll
            for (int j = 0; j < 4; ++j) { v2u w; w.x = pkh2(h[q][j].x, h[q][j].y); w.y = pkh2(h[q][j].z, h[q][j].w); ((GAS v2u*)(P.Hb + (size_t)(row0 + q * rstride) * DM))[lane + 64 * j] = w; }
    }
    if (P.pre) {
#pragma unroll
        for (int q = 0; q < NR; ++q) {
            float s = 0.f;
#pragma unroll
            for (int j = 0; j < 4; ++j) s += (h[q][j].x * h[q][j].x + h[q][j].y * h[q][j].y) + (h[q][j].z * h[q][j].z + h[q][j].w * h[q][j].w);
            const float rstd = 1.f / sqrtf(wave_sum(s) * (1.f / DM) + EPS);
            const float* shift = P.mod_pre + (size_t)mrow[q] * (NMOD * DM) + P.shift_i * DM; const float* scale = shift + DM;
#pragma unroll
            for (int j = 0; j < 4; ++j) { const f32x4 sh = ((const GAS f32x4*)shift)[lane + 64 * j], sc = ((const GAS f32x4*)scale)[lane + 64 * j], gp = ((const GAS f32x4*)P.gpre)[lane + 64 * j];
                const f32x4 u = (h[q][j] * rstd) * gp * (sc + 1.0f) + sh;
                v2u w; w.x = pk2(u.x, u.y); w.y = pk2(u.z, u.w);
                ((GAS v2u*)(P.U + (size_t)(row0 + q * rstride) * DM))[lane + 64 * j] = w; }
        }
    }
}
__device__ __forceinline__ void ew_pass(const EwParams& P, int gw, int NGW, int lane) {
    int row = gw;
    for (; row + NGW < P.nrows; row += 2 * NGW) ew_rows<2>(P, row, NGW, lane);
    if (row < P.nrows) ew_rows<1>(P, row, 0, lane);
}

struct PanelOrder {
    int nwg, G, v;
    __device__ __forceinline__ void init(int M, int G_, int bid) { nwg = (M / 256) * 4; G = G_; v = (G_ % 8 == 0) ? (bid % 8) * (G_ / 8) + bid / 8 : bid; }
    __device__ __forceinline__ bool next(int i, pg8::Unit& u) const { long L = (long)i * G + v;
        if (G == 256 && nwg == 1056 && i >= 4) { if (i > 4 || (v & 31) >= 4) return false; L = 1024 + 4 * (v >> 5) + (v & 31); }
        if (L >= nwg) return false; u.pm = (int)(L >> 2); u.pn = (int)(L & 3); return true; }
    __device__ __forceinline__ void a_ready(const pg8::Unit&) const {}
    __device__ __forceinline__ void done(const pg8::Unit&) const {}
};
struct SkewOrder : pg8::StaticOrder {
    int k, late, wgm; const unsigned* dcnt;
    __device__ __forceinline__ void init2(int M, int N, int G_, int c_, int k_, const unsigned* done_) { init(M, N, G_, c_); wgm = pg8::WGM; dcnt = done_; k = (G_ == 256 && k_ > 0) ? k_ : (1 << 20); late = ((c_ >> 3) < 4); }
    __device__ __forceinline__ bool next(int i, pg8::Unit& u) const {
        const int x = c & 7, j = c >> 3, per = G >> 3, q = nwg >> 3;
        const int off = (i < k) ? i * per + j : k * per + (i - k) * (per - 4) + (j - 4);
        if ((i >= k && late) || off >= q) return false;
        const int wgid = x * q + off;
        const int nig = wgm * nN, gid = wgid / nig, fm = gid * wgm, gsz = (nM - fm) < wgm ? (nM - fm) : wgm;
        u.pm = fm + ((wgid % nig) % gsz); u.pn = (wgid % nig) / gsz; return true;
    }
    __device__ __forceinline__ void a_ready(const pg8::Unit& u) const {
        if (dcnt != nullptr && u.pm >= 256) {
            if (threadIdx.x < 64) { unsigned spins = 0;
                while ((unsigned)__builtin_amdgcn_readfirstlane(__hip_atomic_load(dcnt + 16 * (u.pm - 256), __ATOMIC_RELAXED, __HIP_MEMORY_SCOPE_AGENT)) < 4u) { __builtin_amdgcn_s_sleep(2); if (++spins > (1u << 22)) break; }
                __builtin_amdgcn_fence(__ATOMIC_ACQUIRE, "agent");
                asm volatile("s_waitcnt vmcnt(0)" ::: "memory"); }
            asm volatile("" ::: "memory"); __builtin_amdgcn_s_barrier(); asm volatile("" ::: "memory");
        }
    }
};
struct RowStats {
    float* xbuf; unsigned* cnt;
    __device__ __forceinline__ void run(const pg8::f32x4 (&v)[2][2][4][2], const pg8::Unit& u, int wr, int wc, int fr, int fq, LAS unsigned char* sl, int wid, int lane) const {
        LAS float* Pp = (LAS float*)sl; LAS float* S = (LAS float*)(sl + 4096);
#pragma unroll
        for (int ai = 0; ai < 2; ++ai)
#pragma unroll
            for (int m = 0; m < 4; ++m) { float q = 0.f;
#pragma unroll
                for (int bj = 0; bj < 2; ++bj)
#pragma unroll
                    for (int n = 0; n < 2; ++n) { const pg8::f32x4 d = v[ai][bj][m][n]; q += (d[0] * d[0] + d[1] * d[1]) + (d[2] * d[2] + d[3] * d[3]); }
                q += __shfl_xor(q, 16); q += __shfl_xor(q, 32);
                if (fq == 0) Pp[(ai * 128 + wr * 64 + m * 16 + fr) * 4 + wc] = q; }
        asm volatile("s_waitcnt lgkmcnt(0)" ::: "memory"); __builtin_amdgcn_s_barrier(); asm volatile("" ::: "memory");
        const int row = wid * 32 + (lane & 31);
        if (lane < 32) { const float s = (Pp[row * 4 + 0] + Pp[row * 4 + 1]) + (Pp[row * 4 + 2] + Pp[row * 4 + 3]);
            __hip_atomic_store(xbuf + ((size_t)(u.pm * 256 + row) * 4 + u.pn), s, __ATOMIC_RELAXED, __HIP_MEMORY_SCOPE_AGENT); }
        asm volatile("s_waitcnt vmcnt(0)" ::: "memory");
        if (lane == 0) __hip_atomic_fetch_add(cnt + 16 * u.pm, 1u, __ATOMIC_RELAXED, __HIP_MEMORY_SCOPE_AGENT);
        if (wid == 0) { unsigned spins = 0;
            while ((unsigned)__builtin_amdgcn_readfirstlane(__hip_atomic_load(cnt + 16 * u.pm, __ATOMIC_RELAXED, __HIP_MEMORY_SCOPE_AGENT)) < 32u) { __builtin_amdgcn_s_sleep(1); if (++spins > (1u << 22)) break; } }
        asm volatile("s_waitcnt vmcnt(0) lgkmcnt(0)" ::: "memory"); __builtin_amdgcn_s_barrier(); asm volatile("" ::: "memory");
        if (lane < 32) { const float* slot = xbuf + (size_t)(u.pm * 256 + row) * 4; float s = 0.f;
#pragma unroll
            for (int t = 0; t < 4; ++t) s += __hip_atomic_load(slot + t, __ATOMIC_RELAXED, __HIP_MEMORY_SCOPE_AGENT);
            S[row] = s; }
        asm volatile("s_waitcnt lgkmcnt(0)" ::: "memory"); __builtin_amdgcn_s_barrier(); asm volatile("" ::: "memory");
    }
};
struct EpiRmsResPre {
    static constexpr int NPRE = 6;
    static constexpr bool PERM = true, AFTER_DRAIN = false;
    EwParams P; RowStats st1, st2; LAS unsigned char* sl; int skew; int G; XcdBarrier xb; unsigned* done;
    __device__ __forceinline__ void operator()(pg8::f32x4 (&acc)[2][2][4][2], const pg8::Unit& u, int wr, int wc, int fr, int fq) const {
        asm volatile("" : "+v"(fr), "+v"(fq));
        const int wid = wr * 4 + wc, lane = fq * 16 + fr, pm = u.pm;
        const LAS float* S = (const LAS float*)(sl + 4096);
        const bool lat = pm < 256; const int mrow = lat ? (pm >> 5) : 8;
        const int col0 = u.pn * 256 + wc * 32 + 8 * fq;
        bf16* hb = P.Hb + (size_t)(pm * 256 + wr * 64 + fr) * DM + col0;
        float* fout = P.hout_lat + (size_t)(pm * 256 + wr * 64 + fr) * DM + col0;
        pg8::u32x4 pre[NPRE][2];
#pragma unroll
        for (int m = 0; m < NPRE; ++m)
#pragma unroll
            for (int bj = 0; bj < 2; ++bj) pre[m][bj] = *(const pg8::u32x4*)(hb + (size_t)((m >> 2) * 128 + (m & 3) * 16) * DM + bj * 128);
        st1.run(acc, u, wr, wc, fr, fq, sl, wid, lane);
        {
            const float* gate = P.mod_post + (size_t)mrow * (NMOD * DM) + P.gate_i * DM + col0; const float* gpost = P.gpost + col0;
#pragma unroll
            for (int ai = 0; ai < 2; ++ai)
#pragma unroll
                for (int m = 0; m < 4; ++m) { const int r = ai * 128 + m * 16; const float rstd = P.wres / sqrtf(S[r + wr * 64 + fr] * (1.f / DM) + EPS);
#pragma unroll
                    for (int bj = 0; bj < 2; ++bj) { const pg8::u32x4 hw = (ai * 4 + m < NPRE) ? pre[ai * 4 + m < NPRE ? ai * 4 + m : 0][bj] : *(const pg8::u32x4*)(hb + (size_t)r * DM + bj * 128);
                        const f32x2h ha = uph2(hw.x), hbv = uph2(hw.y), hc = uph2(hw.z), hd = uph2(hw.w); const pg8::f32x4 h0 = {ha.x, ha.y, hbv.x, hbv.y}, h1 = {hc.x, hc.y, hd.x, hd.y};
                        const pg8::f32x4 g0 = *(const pg8::f32x4*)(gate + bj * 128) * *(const pg8::f32x4*)(gpost + bj * 128), g1 = *(const pg8::f32x4*)(gate + bj * 128 + 4) * *(const pg8::f32x4*)(gpost + bj * 128 + 4);
                        acc[ai][bj][m][0] = h0 + g0 * (acc[ai][bj][m][0] * rstd); acc[ai][bj][m][1] = h1 + g1 * (acc[ai][bj][m][1] * rstd); }
                    asm volatile("" : "+v"(acc[ai][0][m][0]), "+v"(acc[ai][0][m][1]), "+v"(acc[ai][1][m][0]), "+v"(acc[ai][1][m][1]));
                    if (m & 1) asm volatile("" ::: "memory"); }
        }
        if (P.pre) st2.run(acc, u, wr, wc, fr, fq, sl, wid, lane);
        const float* shift = P.mod_pre + (size_t)mrow * (NMOD * DM) + P.shift_i * DM + col0; const float* scale = shift + DM; const float* gpre = P.gpre + col0;
        bf16* up = P.U + (size_t)pm * 256 * DM + (size_t)(wr * 64 + fr) * DM + col0;
#pragma unroll
        for (int ai = 0; ai < 2; ++ai)
#pragma unroll
            for (int m = 0; m < 4; ++m) { const int r = ai * 128 + m * 16; const float rstd = 1.f / sqrtf(S[r + wr * 64 + fr] * (1.f / DM) + EPS);
#pragma unroll
                for (int bj = 0; bj < 2; ++bj) {
                    const pg8::f32x4 x0 = acc[ai][bj][m][0], x1 = acc[ai][bj][m][1];
                    if (P.fin) { *(pg8::f32x4*)(fout + (size_t)r * DM + bj * 128) = x0; *(pg8::f32x4*)(fout + (size_t)r * DM + bj * 128 + 4) = x1; }
                    else { pg8::u32x4 w; w.x = pkh2(x0[0], x0[1]); w.y = pkh2(x0[2], x0[3]); w.z = pkh2(x1[0], x1[1]); w.w = pkh2(x1[2], x1[3]); *(pg8::u32x4*)(hb + (size_t)r * DM + bj * 128) = w; }
                    if (P.pre) { const pg8::f32x4 o0 = (x0 * rstd) * (*(const pg8::f32x4*)(gpre + bj * 128) * (*(const pg8::f32x4*)(scale + bj * 128) + 1.0f)) + *(const pg8::f32x4*)(shift + bj * 128),
                                               o1 = (x1 * rstd) * (*(const pg8::f32x4*)(gpre + bj * 128 + 4) * (*(const pg8::f32x4*)(scale + bj * 128 + 4) + 1.0f)) + *(const pg8::f32x4*)(shift + bj * 128 + 4);
                        *(pg8::u32x4*)(up + (size_t)r * DM + bj * 128) = pg8::pack8(o0, o1); } }
                asm volatile("" ::: "memory"); }
        if (skew) {
            const int L = 4 * pm + u.pn;
            if (pm >= 256) {
                asm volatile("s_waitcnt vmcnt(0)" ::: "memory");
                asm volatile("" ::: "memory"); __builtin_amdgcn_s_barrier(); asm volatile("" ::: "memory");
                if (wid == 0 && lane == 0) { __builtin_amdgcn_fence(__ATOMIC_RELEASE, "agent"); asm volatile("s_waitcnt vmcnt(0)" ::: "memory");
                    __hip_atomic_fetch_add(done + 16 * (pm - 256), 1u, __ATOMIC_RELAXED, __HIP_MEMORY_SCOPE_AGENT); }
            } else if (L >= 768 && ((L - 768) & 31) < 4) {
                xcd_barrier(xb);
            }
        }
    }
};

__global__ void __launch_bounds__(NWAVES * 64, 2) fwd_mega(Args args) {
    extern __shared__ __attribute__((aligned(16))) unsigned char lds[];
    cg::grid_group grid = cg::this_grid();
    LAS unsigned char* ldsL = (LAS unsigned char*)lds;
    for (int u_ = threadIdx.x; u_ < (LDS_BYTES - RING_BYTES) / 4; u_ += NWAVES * 64) ((LAS unsigned*)(ldsL + RING_BYTES))[u_] = 0u;
    __syncthreads();
    const XcdBarrier xbar = xcd_barrier_post((unsigned*)(((const __attribute__((address_space(4))) Args*)__builtin_amdgcn_kernarg_segment_ptr())->ws + WS_CTL), (volatile LAS unsigned*)(ldsL + MISC_OFF) + 8);
#ifdef PROBE_GEMM2
#define PROBE_G2X for (int rep_ = 0; rep_ < 2; ++rep_)
#else
#define PROBE_G2X
#endif
#ifdef ALIGN_OFF
#define PG_ALIGN false
#else
#define PG_ALIGN true
#endif
#ifndef SW_WGM
#define SW_WGM 8
#endif
#ifndef SKEW_ALL
#define SKEW_ALL 1
#endif
#ifndef SKEW_ON
#define SKEW_ON 1
#endif
#ifdef USE_CG_SYNC
#define GSYNC() grid.sync()
#else
#define GSYNC() xcd_barrier(xbar)
#endif
    const int tid = threadIdx.x, lane = tid & 63, wave = __builtin_amdgcn_readfirstlane(tid >> 6);
    const int G = gridDim.x, bid = blockIdx.x;
    const int gw = bid * NWAVES + wave, NGW = G * NWAVES;
    typedef const __attribute__((address_space(4))) Args* kargs_t;
#define KARGS() ({ kargs_t p_ = (kargs_t)__builtin_amdgcn_kernarg_segment_ptr(); asm volatile("" : "+s"(p_)); p_; })
#define IN_(i) ((const float*)KARGS()->in[i])
#define WS_() ((unsigned char*)KARGS()->ws)
#define p_x IN_(0)
#define p_c_in IN_(1)
#define p_ctx IN_(2)
#define p_c_ctx IN_(3)
#define p_w_ada IN_(4)
#define p_b_ada IN_(5)
#define p_norm_g IN_(6)
#define p_w_in IN_(7)
#define p_qk_g IN_(8)
#define p_rpb IN_(9)
#define p_conv_w IN_(10)
#define p_w_o IN_(11)
#define p_ffn_wi IN_(12)
#define p_ffn_wo IN_(13)
#define p_ws WS_()
#define p_MOD ((float*)(WS_() + WS_MOD))
#define p_ROPEC ((float*)(WS_() + WS_ROPE))
#define p_ROPES (p_ROPEC + 128 * 16)
#define p_HC ((float*)(WS_() + WS_HC))
#define p_U ((bf16*)(WS_() + WS_U))
#define p_Y ((bf16*)(WS_() + WS_Y))
#define p_HID ((bf16*)(WS_() + WS_HID))
#define p_QB ((bf16*)(WS_() + WS_QB))
#define p_KVB ((bf16*)(WS_() + WS_KVB))
#define p_Z ((bf16*)(WS_() + WS_Z))
#define p_CB ((bf16*)(WS_() + WS_CB))
#define p_O ((bf16*)(WS_() + WS_O))
#define p_H ((float*)KARGS()->out)
#ifdef PROBE_P02
    for (int rep_ = 0; rep_ < 2; ++rep_)
#endif
    {
        LAS float* scr = (LAS float*)(ldsL + wave * 16384);
        constexpr int I_WI = (DM / 64) * (2 * FF / 32), I_WD = (FF / 64) * (DM / 32), I_WIN = (DM / 64) * (NPROJ / 32), I_WO = (DM / 64) * (DM / 32);
        constexpr int I_LAYER = 2 * I_WI + 2 * I_WD + I_WIN + I_WO;
        for (int it = gw; it < DEPTH * I_LAYER; it += NGW) {
            const int L = it / I_LAYER; int r = it % I_LAYER; unsigned char* wl = p_ws + WS_W + L * W_LAYER;
            if (r < 2 * I_WI) { const int k = r / I_WI; transpose_item(p_ffn_wi + (size_t)(L * 2 + k) * DM * 2 * FF, DM, 2 * FF, (bf16*)(wl + WO_WI) + (size_t)k * 2 * FF * DM, 1, scr, r % I_WI, lane); continue; } r -= 2 * I_WI;
            if (r < 2 * I_WD) { const int k = r / I_WD; transpose_item(p_ffn_wo + (size_t)(L * 2 + k) * FF * DM, FF, DM, (bf16*)(wl + WO_WD) + (size_t)k * DM * FF, 0, scr, r % I_WD, lane); continue; } r -= 2 * I_WD;
            if (r < I_WIN) { transpose_item(p_w_in + (size_t)L * DM * NPROJ, DM, NPROJ, (bf16*)(wl + WO_WIN), 2, scr, r, lane); continue; } r -= I_WIN;
            transpose_item(p_w_o + (size_t)L * DM * DM, DM, DM, (bf16*)(wl + WO_WO), 0, scr, r, lane);
        }
        __syncthreads();
        LAS float* sc = (LAS float*)ldsL;
        LAS float* part = (LAS float*)(ldsL + 40960);
        const float* cinp = p_c_in; const float* cctxp = p_c_ctx;
        for (int i = tid; i < 9 * DM; i += NWAVES * 64) { const float v = (i < 8 * DM) ? cinp[i] : cctxp[i - 8 * DM]; sc[i] = v / (1.0f + __expf(-v)); }
        __syncthreads();
        float* MODp = p_MOD; const float* badap = p_b_ada; const float* wadap = p_w_ada;
        for (int it = bid; it < DEPTH * (NMOD * DM / 64); it += G) {
            const int L = it / (NMOD * DM / 64), n0 = (it % (NMOD * DM / 64)) * 64;
            const float* wp = wadap + (size_t)L * DM * (NMOD * DM) + (size_t)(wave * 128) * (NMOD * DM) + n0 + lane;
            float a[9];
#pragma unroll
            for (int r = 0; r < 9; ++r) a[r] = 0.f;
#pragma unroll 8
            for (int k = 0; k < 128; ++k) { const float wv = wp[(size_t)k * (NMOD * DM)];
#pragma unroll
                for (int r = 0; r < 9; ++r) a[r] += sc[r * DM + wave * 128 + k] * wv; }
#pragma unroll
            for (int r = 0; r < 9; ++r) part[(wave * 9 + r) * 64 + lane] = a[r];
            __syncthreads();
            for (int i = tid; i < 9 * 64; i += NWAVES * 64) { float s = 0.f;
#pragma unroll
                for (int w = 0; w < 8; ++w) s += part[w * 576 + i];
                const int r = i >> 6, n = n0 + (i & 63);
                MODp[((size_t)L * 9 + r) * (NMOD * DM) + n] = s + badap[(size_t)L * NMOD * DM + n]; }
            __syncthreads();
        }
        for (int i = bid * (NWAVES * 64) + tid; i < 128 * 16; i += G * NWAVES * 64) { const int pos = i >> 4, f = i & 15;
            const float freq = 1.0f / powf(10000.0f, (float)f / 16.0f); const float ang = (float)pos * freq; float* rc_ = p_ROPEC; rc_[i] = cosf(ang); rc_[i + 2048] = sinf(ang); }
    }
    grid.sync();
    {
        EwParams P; P.hin_lat = p_x; P.hin_ctx = p_ctx; P.hout_lat = (float*)P.hin_lat; P.hout_ctx = (float*)P.hin_ctx; P.Y = p_Y; P.U = p_U; P.nrows = MT; P.post = 0; P.pre = 1; P.wres = 0.f; P.Hb = p_Y; P.fin = 0; P.hb_store = 1;
        P.mod_post = p_MOD; P.gate_i = 0; P.gpost = p_norm_g; P.mod_pre = p_MOD; P.shift_i = 0; P.gpre = p_norm_g;
        ew_pass(P, gw, NGW, lane);
    }
    GSYNC();

    for (int L = 0; L < DEPTH; ++L) {
        const bool last = (L == DEPTH - 1);
#define wl (p_ws + WS_W + L * W_LAYER)
#define MODL (p_MOD + (size_t)L * 9 * NMOD * DM)
#define gL (p_norm_g + (size_t)L * 6 * DM)
        for (int sg = 0; sg < 3; ++sg) {
            bool did_bar = false;
            int tid = threadIdx.x; asm volatile("" : "+v"(tid)); const int lane = tid & 63, wave = __builtin_amdgcn_readfirstlane(tid >> 6), gw = bid * NWAVES + wave;
            const int Mrows = (last && sg >= 1) ? ML : MT;
            if (sg != 1) {
                pg8::Gemm g{p_U, (const bf16*)(wl + WO_WI) + (size_t)(sg >> 1) * 2 * FF * DM, Mrows, 2 * FF, DM}; SkewOrder S; { const bool sk = SKEW_ON && SKEW_ALL && ((L == 0 && sg == 2) || (L == 1 && sg == 0)); const int pbank = (sg == 2) ? L * 3 + 1 : (L - 1) * 3 + 2;
                    S.init2(Mrows, 2 * FF, G, bid, sk ? SKEW_K1 : 0, sk ? (const unsigned*)(p_ws + WS_CTL + 409600) + (size_t)pbank * 128 : nullptr); S.wgm = SW_WGM; }
                pg8::EpiSwiglu E{p_HID, FF};
#ifndef NO_GSW
                PROBE_G2X pg8::gemm_phase<pg8::EpiSwiglu, SkewOrder, PG_ALIGN, true>(ldsL, g, S, E);
#endif
                GSYNC();
            } else {
                {
                    pg8::Gemm g{p_U, (const bf16*)(wl + WO_WIN), MT, NPROJ, DM}; SkewOrder S; S.init2(MT, NPROJ, G, bid, SKEW_ON ? SKEW_K3 : 0, (const unsigned*)(p_ws + WS_CTL + 409600) + (size_t)(L * 3 + 0) * 128);
                    pg8::EpiInProj E{p_QB, p_KVB, p_Z, p_CB, p_qk_g + (size_t)L * 128, p_ROPEC, p_ROPES};
#ifndef NO_GIN
                    PROBE_G2X pg8::gemm_phase<pg8::EpiInProj, SkewOrder, PG_ALIGN, true>(ldsL, g, S, E);
#endif
                }
                GSYNC();
#ifdef PROBE_ATT2
                for (int rep_ = 0; rep_ < 2; ++rep_)
#endif
                {
                    using attn_body::AttnJob;
                    const int nA = NB * 6 * 32, nC = last ? 0 : NB * 12;
                    bool nomax;
                    {
                        const float* gp = p_qk_g + (size_t)L * 128; float gq = fabsf(gp[lane]), gk = fabsf(gp[64 + lane]);
#pragma unroll
                        for (int o_ = 1; o_ < 64; o_ <<= 1) { gq = fmaxf(gq, __shfl_xor(gq, o_)); gk = fmaxf(gk, __shfl_xor(gk, o_)); }
                        nomax = (64.0f * gq * gk * 0.125f * LOG2E * 1.05f) < 40.0f;
                    }
                    for (int w = bid; w < nA + nC; w += G) {
                        AttnJob J; J.qp = 768; J.kvp = 1024; J.op = 1024; J.seg1 = 0; J.r0 = 0; J.lo = 0; J.biasL = (attn_body::lds_cfptr)(ldsL + BIAS_OFF);
                        if (w < nA) {
                            int grp, h3, qb;
                            if (G == 256) { const int i = w >> 8, xx = bid & 7, v = bid >> 3; grp = 2 * xx + i / 3; h3 = i % 3; qb = v; }
                            else { grp = w / 96; const int rem = w % 96; h3 = rem >> 5; qb = rem & 31; }
                            const int b = grp >> 1, kvh = grp & 1, hq = kvh * 3 + h3;
                            J.Q0 = (const attn_body::bf16*)(p_QB + (size_t)(b * SEQ + qb * 256) * 768 + 64 * hq);
                            J.K0 = (const attn_body::bf16*)(p_KVB + (size_t)(b * KVS) * 1024 + 64 * kvh);
                            J.V0 = (const attn_body::bf16*)(p_KVB + (size_t)(b * KVS) * 1024 + 128 + 64 * kvh);
                            J.O0 = (attn_body::bf16*)(p_O + (size_t)(b * SEQ + qb * 256) * 1024 + 64 * hq);
                            J.NT = KVS / 64; J.nt0 = KVS / 64;
                        } else {
                            const int ci = w - nA, b = ci / 12, hh = ci % 12;
                            const int qcol = (hh < 6) ? 64 * hh : 384 + 64 * (hh - 6), kcol = (hh < 6) ? 64 * (hh / 3) : 256 + 64 * (hh - 6), vcol = (hh < 6) ? 128 + 64 * (hh / 3) : 640 + 64 * (hh - 6);
                            J.Q0 = (const attn_body::bf16*)(p_QB + (size_t)(ML + b * CTX) * 768 + qcol);
                            J.K0 = (const attn_body::bf16*)(p_KVB + (size_t)(b * KVS + SEQ) * 1024 + kcol);
                            J.V0 = (const attn_body::bf16*)(p_KVB + (size_t)(b * KVS + SEQ) * 1024 + vcol);
                            J.O0 = (attn_body::bf16*)(p_O + (size_t)(ML + b * CTX) * 1024 + qcol);
                            J.NT = 4; J.nt0 = 4;
                        }
#ifndef NO_ATT0
                        if (nomax && w < nA) attn_body::attn_unit<8, 2>(J, (char*)lds);
                        else attn_body::attn_unit<8, 0>(J, (char*)lds);
#endif
                    }
                    LAS float* biasT = (LAS float*)(ldsL + BIAS_OFF); const float* rpbp = p_rpb;
                    for (int w = bid; w < NB * 6 * 32; w += G) {
                        const int b = w / 192, h = (w >> 5) % 6, rb = w & 31, r0 = 4 * rb, lo = min(max(r0 - 4, 0), 116);
                        for (int i = tid; i < 15 * 31; i += NWAVES * 64) biasT[i] = rpbp[((size_t)L * 6 + h) * 465 + i] * LOG2E;
                        AttnJob J; J.qp = 768; J.kvp = 1024; J.op = 1024; J.biasL = (attn_body::lds_cfptr)biasT; J.r0 = r0; J.lo = lo;
                        J.Q0 = (const attn_body::bf16*)(p_QB + (size_t)(b * SEQ + rb * 256) * 768 + 384 + 64 * h);
                        J.K0 = (const attn_body::bf16*)(p_KVB + (size_t)(b * KVS + SEQ) * 1024 + 256 + 64 * h);
                        J.V0 = (const attn_body::bf16*)(p_KVB + (size_t)(b * KVS + SEQ) * 1024 + 640 + 64 * h);
                        J.O0 = (attn_body::bf16*)(p_O + (size_t)(b * SEQ + rb * 256) * 1024 + 384 + 64 * h);
                        J.NT = 16; J.nt0 = 4; J.seg1 = 64 * lo - SEQ;
#ifndef NO_ATT1
                        attn_body::attn_unit<8, 1>(J, (char*)lds);
#endif
                    }
                    const float* cw = p_conv_w + (size_t)L * 3 * 256; const bf16* Zp = p_Z; const bf16* CBp = p_CB; bf16* Op = p_O;
                    const int nrow = last ? ML : MT;
                    for (int idx = bid * (NWAVES * 64) + tid; idx < nrow * 32; idx += G * NWAVES * 64) {
                        const int row = idx >> 5, c8 = (idx & 31) * 8;
                        const int t = (row < ML) ? (row & (SEQ - 1)) : ((row - ML) & (CTX - 1)); const int tl = (row < ML) ? SEQ - 1 : CTX - 1;
                        const v4u zc = *(const GAS v4u*)(Zp + (size_t)row * 256 + c8);
                        v4u zp = {0u, 0u, 0u, 0u}, zn = {0u, 0u, 0u, 0u};
                        if (t > 0) zp = *(const GAS v4u*)(Zp + (size_t)(row - 1) * 256 + c8);
                        if (t < tl) zn = *(const GAS v4u*)(Zp + (size_t)(row + 1) * 256 + c8);
                        const v4u cb = *(const GAS v4u*)(CBp + (size_t)row * 256 + c8);
                        v4u o;
#pragma unroll
                        for (int q = 0; q < 4; ++q) {
                            const int ch = c8 + 2 * q;
                            const float y0 = cw[ch] * bf2f(zp[q] & 0xffffu) + cw[256 + ch] * bf2f(zc[q] & 0xffffu) + cw[512 + ch] * bf2f(zn[q] & 0xffffu);
                            const float y1 = cw[ch + 1] * bf2f(zp[q] >> 16) + cw[256 + ch + 1] * bf2f(zc[q] >> 16) + cw[512 + ch + 1] * bf2f(zn[q] >> 16);
                            o[q] = pk2(bf2f(cb[q] & 0xffffu) * y0, bf2f(cb[q] >> 16) * y1);
                        }
                        *(GAS v4u*)(Op + (size_t)row * 1024 + 768 + c8) = o;
                    }
                }
                GSYNC();
            }
            {
                const bool fin = last && sg == 2;
                const int nL = (sg == 2) ? L + 1 : L, nsg = (sg == 2) ? 0 : sg + 1;
                EwParams P; P.hout_lat = p_H; P.hout_ctx = p_HC; P.hin_lat = P.hout_lat; P.hin_ctx = P.hout_ctx; P.Y = p_Y; P.U = p_U; P.Hb = p_Y; P.fin = fin ? 1 : 0; P.hb_store = 0; P.nrows = Mrows; P.post = 1; P.pre = fin ? 0 : 1; P.wres = (sg == 1) ? 1.0f : 0.5f;
                P.mod_post = MODL; P.gate_i = 3 * sg + 2; P.gpost = gL + (2 * sg + 1) * DM;
                P.mod_pre = fin ? P.mod_post : p_MOD + (size_t)nL * 9 * NMOD * DM; P.shift_i = 3 * nsg; P.gpre = fin ? P.gpost : p_norm_g + ((size_t)nL * 6 + 2 * nsg) * DM;
                const bf16* A = (sg == 1) ? p_O : p_HID; const int K = (sg == 1) ? DM : FF;
                const bf16* Bt = (sg == 1) ? (const bf16*)(wl + WO_WO) : (const bf16*)(wl + WO_WD) + (size_t)(sg >> 1) * DM * FF;
                pg8::Gemm g{A, Bt, Mrows, DM, K}; PanelOrder S; S.init(Mrows, G, bid);
                const int bank = L * 3 + sg;
                unsigned* cbase = (unsigned*)(p_ws + WS_CTL + 65536) + (size_t)bank * 2 * (264 * 16);
                float* xb = (float*)(p_ws + WS_XB) + (size_t)bank * 2 * ((size_t)MT * 4);
                const int skew = (SKEW_ON && G == 256 && Mrows == MT && (SKEW_ALL || sg == 0)) ? 1 : 0;
                unsigned* dn = (unsigned*)(p_ws + WS_CTL + 409600) + (size_t)bank * 128;
                did_bar = skew && ((S.v & 31) < 4);
                EpiRmsResPre E{P, RowStats{xb, cbase}, RowStats{xb + (size_t)MT * 4, cbase + 264 * 16}, ldsL + XS_OFF, skew, G, xbar, dn};
#ifndef NO_GST
                PROBE_G2X pg8::gemm_phase<EpiRmsResPre, PanelOrder, true, true>(ldsL, g, S, E);
#endif
            }
            if (!(last && sg == 2) && !did_bar) GSYNC();
        }
    }
}

extern "C" void kernel_launch(void* const* d_in, const int* in_sizes, int n_in, void* d_out, int out_size, void* d_ws, size_t ws_size, hipStream_t stream) {
    static int grid = 0;
    if (grid == 0) {
        if (n_in != 14 || out_size != ML * DM || ws_size < WS_END2) { fprintf(stderr, "kernel_launch: unexpected shapes (n_in %d out %d ws %zu)\n", n_in, out_size, ws_size); grid = -1; return; }
        int dev = 0, cus = 0, per_cu = 0;
        if (hipGetDevice(&dev) != hipSuccess || hipDeviceGetAttribute(&cus, hipDeviceAttributeMultiprocessorCount, dev) != hipSuccess) { grid = -1; return; }
        if (hipFuncSetAttribute((const void*)fwd_mega, hipFuncAttributeMaxDynamicSharedMemorySize, LDS_BYTES) != hipSuccess) { fprintf(stderr, "kernel_launch: hipFuncSetAttribute failed\n"); grid = -1; return; }
        if (hipOccupancyMaxActiveBlocksPerMultiprocessor(&per_cu, (const void*)fwd_mega, NWAVES * 64, LDS_BYTES) != hipSuccess || per_cu < 1) per_cu = 1;
        (void)hipGetLastError();
        grid = cus * per_cu;
        fprintf(stderr, "kernel_launch: grid %d (cus %d x %d)\n", grid, cus, per_cu);
    }
    if (grid < 0) return;
    if (hipMemsetAsync((char*)d_ws + WS_CTL, 0, CTL_BYTES, stream) != hipSuccess) { fprintf(stderr, "kernel_launch: memset failed\n"); return; }
    Args a{};
    for (int i = 0; i < 14; ++i) a.in[i] = (const float*)d_in[i];
    a.out = (float*)d_out; a.ws = (unsigned char*)d_ws;
    void* kargs[] = {&a};
    const hipError_t e = hipLaunchCooperativeKernel((const void*)fwd_mega, dim3(grid), dim3(NWAVES * 64), kargs, LDS_BYTES, stream);
    if (e != hipSuccess) fprintf(stderr, "kernel_launch: cooperative launch failed: %s (grid %d)\n", hipGetErrorString(e), grid);
}
```
